# Optimizing an MI355X kernel written in HIP

```python
import math
import jax, jax.numpy as jnp
from jax import lax
import numpy as np

D_MODEL = 1024
BATCH = 8
SEQ = 4096
DEPTH = 1
DEC_BATCH = 8
DEC_SEQ = 8192
PAST_LEN = 128

RET_HEADS = 4
RET_DK = 128
RET_DV = 256
RET_CHUNK = 128
MLA_HEADS = 8
MLA_NOPE = 128
MLA_ROPE = 64
MLA_V = 128
MLA_QK = MLA_NOPE + MLA_ROPE
Q_LORA = 384
KV_LORA = 256
Q_BLOCK = 128
D_FF = 2816
CONV_W = 3
ROPE_BASE = 10000.0
EPS = 1e-6

RET_Q_W = RET_HEADS * RET_DK
RET_V_W = RET_HEADS * RET_DV
MLA_O_W = MLA_HEADS * MLA_V
IN_SPLITS = (RET_Q_W, RET_Q_W, RET_V_W, RET_V_W, Q_LORA, KV_LORA, MLA_ROPE, D_MODEL, D_MODEL)
IN_W = sum(IN_SPLITS)
IN_SPLIT_POINTS = tuple(int(v) for v in np.cumsum(IN_SPLITS)[:-1])

kernel_name = "hybrid_retention_mla_encoder"


def rms_norm(x, g):
    xf = x.astype(jnp.float32)
    y = xf * lax.rsqrt(jnp.mean(xf * xf, axis=-1, keepdims=True) + EPS)
    return (y * g.astype(jnp.float32)).astype(x.dtype)


def head_group_norm(x, g):
    b, s, h, dv = x.shape
    xf = x.astype(jnp.float32)
    mu = jnp.mean(xf, axis=-1, keepdims=True)
    xc = xf - mu
    y = xc * lax.rsqrt(jnp.mean(xc * xc, axis=-1, keepdims=True) + EPS)
    return (y.reshape(b, s, h * dv) * g.astype(jnp.float32)).astype(x.dtype)


def rope(x, pos):
    d = x.shape[-1]
    inv = ROPE_BASE ** (-jnp.arange(0, d, 2, dtype=jnp.float32) / d)
    ang = pos.astype(jnp.float32)[:, None] * inv[None, :]
    cos = jnp.cos(ang)[None, :, None, :].astype(x.dtype)
    sin = jnp.sin(ang)[None, :, None, :].astype(x.dtype)
    x1, x2 = x[..., : d // 2], x[..., d // 2:]
    return jnp.concatenate([x1 * cos - x2 * sin, x1 * sin + x2 * cos], axis=-1)


def retention_one_direction(q, k, v, log_gamma, strict):
    b, s, h, dk = q.shape
    dv = v.shape[-1]
    c = RET_CHUNK
    n = s // c
    idx = jnp.arange(c, dtype=jnp.float32)
    diff = idx[:, None] - idx[None, :]
    mask = (diff > 0) if strict else (diff >= 0)
    dmat = jnp.where(mask[None], jnp.exp(log_gamma[:, None, None] * jnp.maximum(diff, 0.0)[None]), 0.0)
    dmat = dmat.astype(q.dtype)
    q_dec = jnp.exp(log_gamma[None, :] * (idx[:, None] + 1.0)).astype(q.dtype)[None, :, :, None]
    k_dec = jnp.exp(log_gamma[None, :] * (c - 1.0 - idx[:, None])).astype(q.dtype)[None, :, :, None]
    chunk_dec = jnp.exp(log_gamma * c)[None, :, None, None]

    def to_chunks(t):
        return t.reshape(b, n, c, h, t.shape[-1]).transpose(1, 0, 2, 3, 4)

    def step(state, inp):
        qn, kn, vn = inp
        scores = jnp.einsum('bihd,bjhd->bhij', qn, kn) * dmat[None]
        intra = jnp.einsum('bhij,bjhv->bihv', scores, vn)
        cross = jnp.einsum('bihd,bhdv->bihv', qn * q_dec, state.astype(qn.dtype))
        new_state = state * chunk_dec + jnp.einsum('bjhd,bjhv->bhdv', kn * k_dec, vn).astype(jnp.float32)
        return new_state, intra + cross

    state0 = jnp.zeros((b, h, dk, dv), jnp.float32)
    _, out = lax.scan(step, state0, (to_chunks(q), to_chunks(k), to_chunks(v)))
    return out.transpose(1, 0, 2, 3, 4).reshape(b, s, h, dv)


def bidirectional_retention(q, k, v, decay_fwd, decay_bwd):
    lg_f = jax.nn.log_sigmoid(decay_fwd.astype(jnp.float32))
    lg_b = jax.nn.log_sigmoid(decay_bwd.astype(jnp.float32))
    fwd = retention_one_direction(q, k, v, lg_f, False)
    bwd = retention_one_direction(q[:, ::-1], k[:, ::-1], v[:, ::-1], lg_b, True)[:, ::-1]
    return fwd + bwd


def mla_attention(c_q, c_kv, k_rope, pos, g_cq, w_uq, g_ckv, w_ukv, g_qn, g_kn):
    b, s, _ = c_q.shape
    q = (rms_norm(c_q, g_cq) @ w_uq).reshape(b, s, MLA_HEADS, MLA_QK)
    kv = (rms_norm(c_kv, g_ckv) @ w_ukv).reshape(b, s, MLA_HEADS, MLA_NOPE + MLA_V)
    k_nope, v = kv[..., :MLA_NOPE], kv[..., MLA_NOPE:]
    k = jnp.concatenate([k_nope, jnp.broadcast_to(k_rope[:, :, None, :], (b, s, MLA_HEADS, MLA_ROPE))], axis=-1)
    q = rms_norm(q, g_qn)
    k = rms_norm(k, g_kn)
    q = jnp.concatenate([q[..., :MLA_NOPE], rope(q[..., MLA_NOPE:], pos)], axis=-1)
    k = jnp.concatenate([k[..., :MLA_NOPE], rope(k[..., MLA_NOPE:], pos)], axis=-1)
    nb = s // Q_BLOCK
    qb = (q * (MLA_QK ** -0.5)).reshape(b, nb, Q_BLOCK, MLA_HEADS, MLA_QK).transpose(1, 0, 2, 3, 4)

    def attend(q_blk):
        sc = jnp.einsum('bqhd,bkhd->bhqk', q_blk, k).astype(jnp.float32)
        p = jax.nn.softmax(sc, axis=-1).astype(v.dtype)
        return jnp.einsum('bhqk,bkhv->bqhv', p, v)

    o = lax.map(attend, qb)
    return o.transpose(1, 0, 2, 3, 4).reshape(b, s, MLA_O_W)


def depthwise_conv3(u, w, bias):
    up = jnp.pad(u, ((0, 0), (1, 1), (0, 0)))
    return up[:, :-2] * w[0] + up[:, 1:-1] * w[1] + up[:, 2:] * w[2] + bias


def encoder_trunk(x, g_mix, w_in, ret_decay_fwd, ret_decay_bwd, ret_gn_g, w_ret_o,
                  g_cq, w_uq, g_ckv, w_ukv, g_qn, g_kn, w_mla_o, w_out,
                  g_ffn, w_up, conv_w, conv_b, w_down):
    b, s, _ = x.shape
    pos = jnp.arange(s)
    for l in range(DEPTH):
        h = rms_norm(x, g_mix[l])
        proj = h @ w_in[l]
        rq, rk, rv, rg, cq, ckv, kr, gate_r, gate_a = jnp.split(proj, IN_SPLIT_POINTS, axis=-1)
        rq = rope(rq.reshape(b, s, RET_HEADS, RET_DK), pos)
        rk = rope(rk.reshape(b, s, RET_HEADS, RET_DK), pos) * (RET_DK ** -0.5)
        rv = rv.reshape(b, s, RET_HEADS, RET_DV)
        ret = bidirectional_retention(rq, rk, rv, ret_decay_fwd[l], ret_decay_bwd[l])
        ret_branch = (jax.nn.silu(rg) * head_group_norm(ret, ret_gn_g[l])) @ w_ret_o[l]
        kr = rope(kr[:, :, None, :], pos)[:, :, 0, :]
        mla = mla_attention(cq, ckv, kr, pos, g_cq[l], w_uq[l], g_ckv[l], w_ukv[l], g_qn[l], g_kn[l])
        mla_branch = mla @ w_mla_o[l]
        merged = jax.nn.sigmoid(gate_r) * ret_branch + jax.nn.sigmoid(gate_a) * mla_branch
        x = x + merged @ w_out[l]
        h = rms_norm(x, g_ffn[l])
        u = depthwise_conv3(h @ w_up[l], conv_w[l], conv_b[l])
        x = x + (jax.nn.silu(u[..., :D_FF]) * u[..., D_FF:]) @ w_down[l]
    return x


def setup_inputs(seed: int = 0) -> dict:
    key = jax.random.key(seed)
    ks = jax.random.split(key, 24)
    f32 = jnp.float32

    def nrm(k, shape, scale):
        return jax.random.normal(k, shape, f32) * scale

    def gain(k, shape):
        return 1.0 + 0.02 * jax.random.normal(k, shape, f32)

    decay_base = jnp.log(2.0 ** (5.0 + jnp.arange(RET_HEADS, dtype=f32)) - 1.0)
    return {
        "x_prompt": jax.random.normal(ks[0], (BATCH, SEQ, D_MODEL), f32),
        "x_sample": jax.random.normal(ks[1], (DEC_BATCH, DEC_SEQ, D_MODEL), f32),
        "g_mix": gain(ks[2], (DEPTH, D_MODEL)),
        "w_in": nrm(ks[3], (DEPTH, D_MODEL, IN_W), D_MODEL ** -0.5),
        "ret_decay_fwd": decay_base[None] + 0.1 * jax.random.normal(ks[4], (DEPTH, RET_HEADS), f32),
        "ret_decay_bwd": decay_base[None] + 0.1 * jax.random.normal(ks[5], (DEPTH, RET_HEADS), f32),
        "ret_gn_g": gain(ks[6], (DEPTH, RET_V_W)),
        "w_ret_o": nrm(ks[7], (DEPTH, RET_V_W, D_MODEL), RET_V_W ** -0.5),
        "g_cq": gain(ks[8], (DEPTH, Q_LORA)),
        "w_uq": nrm(ks[9], (DEPTH, Q_LORA, MLA_HEADS * MLA_QK), Q_LORA ** -0.5),
        "g_ckv": gain(ks[10], (DEPTH, KV_LORA)),
        "w_ukv": nrm(ks[11], (DEPTH, KV_LORA, MLA_HEADS * (MLA_NOPE + MLA_V)), KV_LORA ** -0.5),
        "g_qn": gain(ks[12], (DEPTH, MLA_QK)),
        "g_kn": gain(ks[13], (DEPTH, MLA_QK)),
        "w_mla_o": nrm(ks[14], (DEPTH, MLA_O_W, D_MODEL), MLA_O_W ** -0.5),
        "w_out": nrm(ks[15], (DEPTH, D_MODEL, D_MODEL), D_MODEL ** -0.5),
        "g_ffn": gain(ks[16], (DEPTH, D_MODEL)),
        "w_up": nrm(ks[17], (DEPTH, D_MODEL, 2 * D_FF), D_MODEL ** -0.5),
        "conv_w": nrm(ks[18], (DEPTH, CONV_W, 2 * D_FF), CONV_W ** -0.5),
        "conv_b": nrm(ks[19], (DEPTH, 2 * D_FF), 0.02),
        "w_down": nrm(ks[20], (DEPTH, D_FF, D_MODEL), D_FF ** -0.5),
    }


def reference(x_prompt, x_sample, g_mix, w_in, ret_decay_fwd, ret_decay_bwd, ret_gn_g, w_ret_o,
              g_cq, w_uq, g_ckv, w_ukv, g_qn, g_kn, w_mla_o, w_out,
              g_ffn, w_up, conv_w, conv_b, w_down):
    weights = (g_mix, w_in, ret_decay_fwd, ret_decay_bwd, ret_gn_g, w_ret_o,
               g_cq, w_uq, g_ckv, w_ukv, g_qn, g_kn, w_mla_o, w_out,
               g_ffn, w_up, conv_w, conv_b, w_down)
    y_prompt = encoder_trunk(x_prompt, *weights)
    y_sample = encoder_trunk(x_sample, *weights)
    return (y_prompt, y_sample)
```

```cpp
#include <hip/hip_runtime.h>
#include <hip/hip_cooperative_groups.h>
#include <cstdio>
#include <cstdint>
namespace cg = cooperative_groups;

#define LAS __attribute__((address_space(3)))
typedef unsigned short bf16_t;
typedef short bf16x8 __attribute__((ext_vector_type(8)));
typedef short s16x4 __attribute__((ext_vector_type(4)));
typedef float f32x4 __attribute__((ext_vector_type(4)));
typedef float f32x2 __attribute__((ext_vector_type(2)));
typedef float f32x16 __attribute__((ext_vector_type(16)));
typedef unsigned u32x4 __attribute__((ext_vector_type(4)));
typedef unsigned u32x2 __attribute__((ext_vector_type(2)));

constexpr int DM = 1024, NP = 32768, TT = 98304;
constexpr int N_IN = 5888, N_UP = 5632, DFF = 2816;
constexpr float EPS = 1e-6f;
constexpr int LDS_BYTES = 163840;
#ifndef DUP_ATTN
#define DUP_ATTN 1
#endif
#ifndef DUP_R1
#define DUP_R1 1
#endif
#ifndef DUP_R3
#define DUP_R3 1
#endif
#ifndef DUP_P5
#define DUP_P5 1
#endif
#ifndef DUP_P7
#define DUP_P7 1
#endif
#ifndef DUP_P8
#define DUP_P8 1
#endif
#ifndef DUP_P2G
#define DUP_P2G 1
#endif
#ifndef DUP_P0
#define DUP_P0 1
#endif
#ifndef DUP_P1
#define DUP_P1 1
#endif
#ifndef DUP_P69
#define DUP_P69 1
#endif
#ifndef DUP_SYNC
#define DUP_SYNC 1
#endif
#ifndef PMASK
#define PMASK 0xFFFFF
#endif
#define PM(k) ((PMASK >> (k)) & 1)

constexpr size_t al256(size_t x) { return (x + 255) / 256 * 256; }
constexpr size_t WS_WIN = 0;
constexpr size_t WS_WUQ = WS_WIN + (size_t)N_IN * 1024 * 2;
constexpr size_t WS_WUKV = WS_WUQ + (size_t)2048 * 384 * 2;
constexpr size_t WS_WRO = WS_WUKV + (size_t)2048 * 256 * 2;
constexpr size_t WS_WMO = WS_WRO + (size_t)1024 * 1024 * 2;
constexpr size_t WS_WOUT = WS_WMO + (size_t)1024 * 1024 * 2;
constexpr size_t WS_WUP = WS_WOUT + (size_t)1024 * 1024 * 2;
constexpr size_t WS_WDN = WS_WUP + (size_t)N_UP * 1024 * 2;
constexpr size_t WS_ROPE = WS_WDN + (size_t)1024 * DFF * 2;
constexpr size_t WS_SSQ = WS_ROPE + (size_t)8192 * 64 * 8;
constexpr size_t WS_GP = WS_SSQ + (size_t)30 * TT * 4;
constexpr size_t WS_BAR = al256(WS_GP + 2048);
constexpr size_t WS_PERM_END = al256(WS_BAR + 16384);
constexpr size_t PT_H1O = 0, PT_RG = 2048, PT_RQ = 4096, PT_RK = 5120, PT_RV = 6144, PT_GR = 8192, PT_GA = 10240, PT_CQ = 12288, PT_CKV = 13056,
                 PT_KR = 13568, PT_Q = 13696, PT_K = 16768, PT_V = 19840, PT_URET = 21888, PT_KV = 23936, PT_END = 28032;
constexpr size_t PT_UR = PT_RQ, PT_G = PT_RQ + 11264;
static_assert(PT_G + 5632 <= PT_END, "ffn overlay");

struct Args { const float* in[21]; float* out; unsigned char* ws; int CH; int ph_lo; int ph_hi; int pad; };

__device__ __forceinline__ unsigned cvt_pk(float lo, float hi) { unsigned r; asm volatile("v_cvt_pk_bf16_f32 %0, %1, %2" : "=v"(r) : "v"(lo), "v"(hi)); return r; }
__device__ __forceinline__ float bflo(unsigned w) { return __uint_as_float(w << 16); }
__device__ __forceinline__ float bfhi(unsigned w) { return __uint_as_float(w & 0xffff0000u); }
__device__ __forceinline__ void st8(bf16_t* p, f32x4 a, f32x4 b) { u32x4 w = {cvt_pk(a[0], a[1]), cvt_pk(a[2], a[3]), cvt_pk(b[0], b[1]), cvt_pk(b[2], b[3])}; *(u32x4*)p = w; }
__device__ __forceinline__ void ld8(const bf16_t* p, f32x4& a, f32x4& b) { u32x4 w = *(const u32x4*)p; a = (f32x4){bflo(w.x), bfhi(w.x), bflo(w.y), bfhi(w.y)}; b = (f32x4){bflo(w.z), bfhi(w.z), bflo(w.w), bfhi(w.w)}; }
__device__ __forceinline__ float sigm(float x) { return __builtin_amdgcn_rcpf(1.f + __builtin_amdgcn_exp2f(x * -1.4426950408889634f)); }
typedef __bf16 bf16x2_t __attribute__((ext_vector_type(2)));
__device__ __forceinline__ unsigned cvt_pk_s(float lo, float hi) { f32x2 v = {lo, hi}; bf16x2_t b = __builtin_convertvector(v, bf16x2_t); return __builtin_bit_cast(unsigned, b); }
__device__ __forceinline__ void st8_s(bf16_t* p, f32x4 a, f32x4 b) { u32x4 w = {cvt_pk_s(a[0], a[1]), cvt_pk_s(a[2], a[3]), cvt_pk_s(b[0], b[1]), cvt_pk_s(b[2], b[3])}; *(u32x4*)p = w; }
__device__ __forceinline__ float wave_sum(float v) {
#pragma unroll
  for (int o = 1; o < 64; o <<= 1) v += __shfl_xor(v, o);
  return v;
}
__device__ __forceinline__ float dot4(f32x4 a) { return (a[0] * a[0] + a[1] * a[1]) + (a[2] * a[2] + a[3] * a[3]); }
__device__ __forceinline__ void lds_barrier() { asm volatile("s_waitcnt lgkmcnt(0)" ::: "memory"); __builtin_amdgcn_s_barrier(); asm volatile("" ::: "memory"); }

struct Bufs {
  bf16_t *H1O, *RG, *RQ, *RK, *RV, *GR, *GA, *CQ, *CKV, *KR, *Q, *K, *V, *URET, *KV, *UR, *G;
  const float* rope; float *ssq_cq, *ssq_ckv, *ssq_kr, *ssq_x1; const float *gqp, *gkp;
  const float *xp, *xs; float* out;
  int g0, slm;
};
__device__ __forceinline__ const float* xrow(const Bufs& b, int g) { return g < NP ? b.xp + (size_t)g * DM : b.xs + (size_t)(g - NP) * DM; }

namespace pg8 {
constexpr int BM = 256, BK = 64, HALF = 128, HTB = HALF * BK * 2, STAGE_BYTES = 8 * HTB, NXCD = 8, WGM = 8;
__host__ __device__ __forceinline__ int lds_byte(int r, int c) { const int st = (r >> 4) * 2 + (c >> 5), rr = r & 15, cc = c & 31, ob = rr * 64 + cc * 2; return st * 1024 + (ob ^ (((ob >> 9) & 1) << 5)); }
__host__ __device__ __forceinline__ void stage_rc(int b, int& R, int& C) { const int st = b / 1024, sb = b % 1024, swz = sb ^ (((sb >> 9) & 1) << 5); R = (st >> 1) * 16 + swz / 64; C = (st & 1) * 32 + (swz % 64) / 2; }
__host__ __device__ __forceinline__ int perm32(int rho) { const int n = rho >> 4, i = rho & 15; return 8 * (i >> 2) + 4 * n + (i & 3); }
struct Unit { int pm, pn; };
struct Gemm { const bf16_t* A; const bf16_t* Bt; int M, N, K, lda; };
struct StaticOrder {
  int nM, nN, nwg, G, c;
  __device__ void init(int M, int N, int G_, int c_) { nM = M / BM; nN = N / BM; nwg = nM * nN; G = G_; c = c_; }
  __device__ bool next(int i, Unit& u) const {
    const long L = (long)i * G + c; if (L >= nwg) return false;
    int wgid = (int)L; { const int q = nwg / NXCD, r = nwg % NXCD, xcd = wgid % NXCD, off = wgid / NXCD; wgid = (xcd < r ? xcd * (q + 1) : r * (q + 1) + (xcd - r) * q) + off; }
    const int nig = WGM * nN, gid = wgid / nig, fm = gid * WGM, gsz = (nM - fm) < WGM ? (nM - fm) : WGM;
    u.pm = fm + ((wgid % nig) % gsz); u.pn = (wgid % nig) / gsz; return true;
  }
};

template <class Epi, class Sched>
__device__ __forceinline__ void gemm_phase(LAS unsigned char* lds, const Gemm g, const Sched& S, const Epi& E) {
  constexpr bool ALIGN_EPI = true;
  int tid_ = threadIdx.x; asm volatile("" : "+v"(tid_));
  const int tid = tid_, wid = __builtin_amdgcn_readfirstlane(tid >> 6), lane = tid & 63, wr = wid >> 2, wc = wid & 3, fr = lane & 15, fq = lane >> 4;
  int K = g.K; asm volatile("" : "+s"(K)); const int nt = K / BK, lda = g.lda;
  unsigned voffA[2], voffB[2];
#pragma unroll
  for (int i = 0; i < 2; ++i) { int R, C; stage_rc(tid * 16 + i * 8192, R, C); const int Rb = (R & ~31) + perm32(R & 31);
    voffA[i] = (unsigned)(R * lda + C) * 2u; voffB[i] = (unsigned)(Rb * K + C) * 2u; }
  const size_t kstep = (size_t)(BK * 2);
  const size_t hstepA = (size_t)HALF * lda * 2, tstepA = 2 * hstepA;
  const size_t hstepB = (size_t)HALF * K * 2, tstepB = 2 * hstepB;
  const unsigned ldsw = (unsigned)wid * 1024u;
  const int aoff = lds_byte(wr * 64 + fr, fq * 8), boff = lds_byte(wc * 32 + fr, fq * 8);
#define PG8_SA(b, h) (((b) * 2 + (h)) * HTB)
#define PG8_SB(b, h) ((4 + (b) * 2 + (h)) * HTB)
#define PG8_STAGE(bufoff, gbase, voff) do { _Pragma("unroll") for (int _i = 0; _i < 2; ++_i) \
    __builtin_amdgcn_global_load_lds((const unsigned*)((const char*)(gbase) + (voff)[_i]), (LAS unsigned*)(lds + (bufoff) + ldsw + _i * 8192), 16, 0, 0); } while (0)
#define PG8_LDA(dst, b, h) do { _Pragma("unroll") for (int m = 0; m < 4; ++m) _Pragma("unroll") for (int k = 0; k < 2; ++k) dst[m][k] = *(const LAS bf16x8*)(lds + PG8_SA(b, h) + aoff + m * 2048 + k * 1024); } while (0)
#define PG8_LDB(dst, b, h) do { _Pragma("unroll") for (int n = 0; n < 2; ++n) _Pragma("unroll") for (int k = 0; k < 2; ++k) dst[n][k] = *(const LAS bf16x8*)(lds + PG8_SB(b, h) + boff + n * 2048 + k * 1024); } while (0)
#define PG8_MMA(ai, bj, At, Bt) do { __builtin_amdgcn_s_setprio(1); _Pragma("unroll") for (int m = 0; m < 4; ++m) _Pragma("unroll") for (int n = 0; n < 2; ++n) _Pragma("unroll") for (int k = 0; k < 2; ++k) \
    acc[ai][bj][m][n] = __builtin_amdgcn_mfma_f32_16x16x32_bf16(Bt[n][k], At[m][k], acc[ai][bj][m][n], 0, 0, 0); __builtin_amdgcn_s_setprio(0); } while (0)
#define PG8_WAIT_V(n) asm volatile("s_waitcnt vmcnt(" #n ")" ::: "memory")
#define PG8_WAIT_L(n) asm volatile("s_waitcnt lgkmcnt(" #n ")" ::: "memory")
#define PG8_BAR __builtin_amdgcn_s_barrier()
#define PG8_SCHED __builtin_amdgcn_sched_barrier(0)
  Unit cur, nxt; int ui = 0;
  if (!S.next(0, cur)) return;
  f32x4 acc[2][2][4][2];
#pragma unroll
  for (int a = 0; a < 2; ++a)
#pragma unroll
    for (int b = 0; b < 2; ++b)
#pragma unroll
      for (int m = 0; m < 4; ++m)
#pragma unroll
        for (int n = 0; n < 2; ++n) acc[a][b][m][n] = (f32x4){0.f, 0.f, 0.f, 0.f};
  bf16x8 At[4][2], B0[2][2], B1[2][2];
  const char* cA = (const char*)g.A + (size_t)cur.pm * tstepA; const char* cB = (const char*)g.Bt + (size_t)cur.pn * tstepB;
  PG8_STAGE(PG8_SB(0, 0), cB, voffB); PG8_STAGE(PG8_SB(0, 1), cB + hstepB, voffB); PG8_STAGE(PG8_SA(0, 0), cA, voffA); PG8_STAGE(PG8_SA(0, 1), cA + hstepA, voffA);
  if (wr == 1) PG8_BAR;
  PG8_WAIT_V(2); PG8_BAR;
  PG8_STAGE(PG8_SB(1, 0), cB + kstep, voffB); PG8_STAGE(PG8_SA(1, 0), cA + kstep, voffA); PG8_STAGE(PG8_SB(1, 1), cB + hstepB + kstep, voffB);
  PG8_WAIT_V(6); PG8_BAR;
  for (;;) {
    const bool has_next = S.next(ui + 1, nxt);
    const char* nA = has_next ? (const char*)g.A + (size_t)nxt.pm * tstepA : cA; const char* nB = has_next ? (const char*)g.Bt + (size_t)nxt.pn * tstepB : cB;
    for (int t = 0; t < nt; t += 2) {
      const bool last = (t == nt - 2);
      const char* a1 = cA + (size_t)(t + 1) * kstep;
      const char* a2 = last ? nA : cA + (size_t)(t + 2) * kstep; const char* b2 = last ? nB : cB + (size_t)(t + 2) * kstep;
      const char* a3 = a2 + kstep; const char* b3 = b2 + kstep;
      PG8_LDB(B0, 0, 0); PG8_LDB(B1, 0, 1); PG8_SCHED; PG8_LDA(At, 0, 0); PG8_STAGE(PG8_SA(1, 1), a1 + hstepA, voffA);
      PG8_WAIT_V(8); PG8_WAIT_L(0); PG8_BAR; PG8_MMA(0, 0, At, B0); PG8_MMA(0, 1, At, B1); PG8_BAR; PG8_SCHED;
      PG8_LDA(At, 0, 1); PG8_STAGE(PG8_SB(0, 0), b2, voffB); PG8_STAGE(PG8_SB(0, 1), b2 + hstepB, voffB); PG8_STAGE(PG8_SA(0, 0), a2, voffA);
      PG8_WAIT_V(8); PG8_WAIT_L(0); PG8_BAR; PG8_MMA(1, 0, At, B0); PG8_MMA(1, 1, At, B1); PG8_BAR; PG8_SCHED;
      PG8_LDB(B0, 1, 0); PG8_LDB(B1, 1, 1); PG8_SCHED; PG8_LDA(At, 1, 0); PG8_STAGE(PG8_SA(0, 1), a2 + hstepA, voffA);
      PG8_WAIT_V(8); PG8_WAIT_L(0); PG8_BAR; PG8_MMA(0, 0, At, B0); PG8_MMA(0, 1, At, B1); PG8_BAR; PG8_SCHED;
      PG8_LDA(At, 1, 1); PG8_STAGE(PG8_SB(1, 0), b3, voffB); PG8_STAGE(PG8_SB(1, 1), b3 + hstepB, voffB); PG8_STAGE(PG8_SA(1, 0), a3, voffA);
      PG8_WAIT_V(8); PG8_WAIT_L(0); PG8_BAR; PG8_MMA(1, 0, At, B0); PG8_MMA(1, 1, At, B1); PG8_BAR; PG8_SCHED;
    }
    if constexpr (ALIGN_EPI) { if (wr == 0) PG8_BAR; }
    { int fr2 = fr, fq2 = fq; asm volatile("" : "+v"(fr2), "+v"(fq2)); E(acc, cur, wr, wc, fr2, fq2, lds + STAGE_BYTES); }
    if (!has_next) break;
#pragma unroll
    for (int a = 0; a < 2; ++a)
#pragma unroll
      for (int b = 0; b < 2; ++b)
#pragma unroll
        for (int m = 0; m < 4; ++m)
#pragma unroll
          for (int n = 0; n < 2; ++n) acc[a][b][m][n] = (f32x4){0.f, 0.f, 0.f, 0.f};
    cur = nxt; cA = nA; cB = nB; ++ui;
    if constexpr (ALIGN_EPI) { if (wr == 1) PG8_BAR; }
  }
  PG8_WAIT_V(0);
  if constexpr (!ALIGN_EPI) { if (wr == 0) PG8_BAR; }
  PG8_BAR;
#undef PG8_SA
#undef PG8_SB
#undef PG8_STAGE
#undef PG8_LDA
#undef PG8_LDB
#undef PG8_MMA
#undef PG8_WAIT_V
#undef PG8_WAIT_L
#undef PG8_BAR
#undef PG8_SCHED
}
}
using pg8::Unit;

#define SBAR0() __builtin_amdgcn_sched_barrier(0)
#define EPI_ARGS const f32x4 (&acc)[2][2][4][2], const Unit& u, int wr, int wc, int fr, int fq, LAS unsigned char* scr
#define FOR_AI_M _Pragma("unroll") for (int ai = 0; ai < 2; ++ai) if ((__builtin_amdgcn_sched_barrier(0), true)) _Pragma("unroll") for (int m = 0; m < 4; ++m)

__device__ __forceinline__ void rope4(f32x4& v0, f32x4& v1, f32x4 t0, f32x4 t1) {
  f32x4 o0 = {v0[0] * t0[0] - v0[1] * t0[1], v0[0] * t0[1] + v0[1] * t0[0], v0[2] * t0[2] - v0[3] * t0[3], v0[2] * t0[3] + v0[3] * t0[2]};
  f32x4 o1 = {v1[0] * t1[0] - v1[1] * t1[1], v1[0] * t1[1] + v1[1] * t1[0], v1[2] * t1[2] - v1[3] * t1[3], v1[2] * t1[3] + v1[3] * t1[2]};
  v0 = o0; v1 = o1;
}

struct EpiIn {
  Bufs b; bool at;
  __device__ __forceinline__ void rope_store(const f32x4 (&acc)[2][2][4][2], bf16_t* dst, float sc, int hsel, int rbase, int wc, int fq) const {
    const int c0 = wc * 32 + fq * 8, i0 = wc * 16 + fq * 4;
    FOR_AI_M { const int row = rbase + ai * 128 + m * 16, pos = (b.g0 + row) & b.slm;
      const f32x4* tp = (const f32x4*)(b.rope + ((size_t)pos * 64 + i0) * 2); const f32x4 t0 = tp[0], t1 = tp[1];
#pragma unroll
      for (int bj = 0; bj < 2; ++bj) { f32x4 v0 = acc[ai][bj][m][0], v1 = acc[ai][bj][m][1]; rope4(v0, v1, t0, t1);
        st8(dst + (size_t)row * 512 + (hsel * 2 + bj) * 128 + c0, v0 * sc, v1 * sc); } }
  }
  template <int ACT> __device__ __forceinline__ void plain_store(const f32x4 (&acc)[2][2][4][2], bf16_t* dst, int cbase, int rbase) const {
    FOR_AI_M { const int row = rbase + ai * 128 + m * 16;
#pragma unroll
      for (int bj = 0; bj < 2; ++bj) { f32x4 v0 = acc[ai][bj][m][0], v1 = acc[ai][bj][m][1];
        if (ACT == 1) {
#pragma unroll
          for (int e = 0; e < 4; ++e) { v0[e] = v0[e] * sigm(v0[e]); v1[e] = v1[e] * sigm(v1[e]); } }
        if (ACT == 2) {
#pragma unroll
          for (int e = 0; e < 4; ++e) { v0[e] = sigm(v0[e]); v1[e] = sigm(v1[e]); } }
        if (ACT == 0) st8(dst + (size_t)row * 1024 + cbase + bj * 128, v0, v1); else st8_s(dst + (size_t)row * 1024 + cbase + bj * 128, v0, v1); } }
  }
  __device__ __forceinline__ void ssq_store(const f32x4 (&acc)[2][2][4][2], bf16_t* dst, int ld, float* sq, int ns, int slot, int rbase, int c0, int fq) const {
    FOR_AI_M { const int row = rbase + ai * 128 + m * 16; float s = 0.f;
#pragma unroll
      for (int bj = 0; bj < 2; ++bj) { const f32x4 v0 = acc[ai][bj][m][0], v1 = acc[ai][bj][m][1]; s += dot4(v0) + dot4(v1); st8(dst + (size_t)row * ld + bj * 128 + c0, v0, v1); }
      s += __shfl_xor(s, 16); s += __shfl_xor(s, 32); if (fq == 0 && at) sq[(size_t)(b.g0 + row) * ns + slot] = s; }
  }
  __device__ __forceinline__ void operator()(EPI_ARGS) const {
    const int pn = u.pn, rbase = u.pm * 256 + wr * 64 + fr, c0 = wc * 32 + fq * 8;
    if (pn < 2) rope_store(acc, b.RQ, 1.f, pn, rbase, wc, fq);
    else if (pn < 4) rope_store(acc, b.RK, 0.08838834764831845f, pn - 2, rbase, wc, fq);
    else if (pn < 8) plain_store<0>(acc, b.RV, (pn - 4) * 256 + c0, rbase);
    else if (pn < 12) plain_store<1>(acc, b.RG, (pn - 8) * 256 + c0, rbase);
    else if (pn < 16) plain_store<2>(acc, b.GR, (pn - 12) * 256 + c0, rbase);
    else if (pn < 20) plain_store<2>(acc, b.GA, (pn - 16) * 256 + c0, rbase);
    else if (pn == 20) ssq_store(acc, b.CQ, 384, b.ssq_cq, 8, wc, rbase, c0, fq);
    else if (pn == 22) ssq_store(acc, b.CKV, 256, b.ssq_ckv, 4, wc, rbase, c0, fq);
    else {
      FOR_AI_M { const int row = rbase + ai * 128 + m * 16, pos = (b.g0 + row) & b.slm;
        { const f32x4 v0 = acc[ai][0][m][0], v1 = acc[ai][0][m][1]; float s = dot4(v0) + dot4(v1); st8(b.CQ + (size_t)row * 384 + 256 + c0, v0, v1);
          s += __shfl_xor(s, 16); s += __shfl_xor(s, 32); if (fq == 0 && at) b.ssq_cq[(size_t)(b.g0 + row) * 8 + 4 + wc] = s; }
        if (wc < 2) { f32x4 v0 = acc[ai][1][m][0], v1 = acc[ai][1][m][1]; const int j0 = wc * 16 + fq * 4;
          const f32x2* tp = (const f32x2*)(b.rope + ((size_t)pos * 64 + 2 * j0) * 2); const f32x2 a0 = tp[0], a1 = tp[2], a2 = tp[4], a3 = tp[6];
          rope4(v0, v1, (f32x4){a0[0], a0[1], a1[0], a1[1]}, (f32x4){a2[0], a2[1], a3[0], a3[1]});
          float s = dot4(v0) + dot4(v1); st8(b.KR + (size_t)row * 64 + c0, v0, v1);
          s += __shfl_xor(s, 16); s += __shfl_xor(s, 32); if (fq == 0 && at) b.ssq_kr[(size_t)(b.g0 + row) * 2 + wc] = s; } }
    }
  }
};

__device__ __forceinline__ void xwave_rowsum(float (&part)[8], int wr, int wc, int fr, int fq, LAS unsigned char* scr) {
  LAS float* red = (LAS float*)scr;
  if (fq == 0) {
#pragma unroll
    for (int i = 0; i < 8; ++i) red[((wr * 4 + wc) * 8 + i) * 16 + fr] = part[i];
  }
  lds_barrier();
#pragma unroll
  for (int i = 0; i < 8; ++i) part[i] = (red[((wr * 4 + 0) * 8 + i) * 16 + fr] + red[((wr * 4 + 1) * 8 + i) * 16 + fr]) + (red[((wr * 4 + 2) * 8 + i) * 16 + fr] + red[((wr * 4 + 3) * 8 + i) * 16 + fr]);
}

struct EpiQ {
  Bufs b;
  __device__ __forceinline__ void operator()(EPI_ARGS) const {
    const int head = u.pn, rbase = u.pm * 256 + wr * 64 + fr, c0 = wc * 32 + fq * 8;
    float part[8];
    FOR_AI_M { float s = 0.f;
#pragma unroll
      for (int bj = 0; bj < 2; ++bj) s += dot4(acc[ai][bj][m][0]) + dot4(acc[ai][bj][m][1]);
      s += __shfl_xor(s, 16); s += __shfl_xor(s, 32); part[ai * 4 + m] = s; }
    xwave_rowsum(part, wr, wc, fr, fq, scr);
    const float* gqp = b.gqp; asm volatile("" : "+s"(gqp));
    const f32x4 g0 = *(const f32x4*)(gqp + c0), g1 = *(const f32x4*)(gqp + c0 + 4), h0 = *(const f32x4*)(gqp + 128 + c0), h1 = *(const f32x4*)(gqp + 128 + c0 + 4);
    FOR_AI_M { const int i = ai * 4 + m, row = rbase + ai * 128 + m * 16, pos = (b.g0 + row) & b.slm;
      const f32x4* sp = (const f32x4*)(b.ssq_cq + (size_t)(b.g0 + row) * 8); const f32x4 s0 = sp[0], s1 = sp[1];
      const float r1 = rsqrtf((((s0[0] + s0[1]) + (s0[2] + s0[3])) + ((s1[0] + s1[1]) + (s1[2] + s1[3]))) * (1.f / 384.f) + EPS);
      const float f = r1 * rsqrtf(r1 * r1 * part[i] * (1.f / 192.f) + EPS) * 0.10411754002f;
      bf16_t* qp = b.Q + (size_t)row * 1536 + head * 192;
      st8(qp + c0, acc[ai][0][m][0] * g0 * f, acc[ai][0][m][1] * g1 * f);
      if (wc < 2) { f32x4 v0 = acc[ai][1][m][0] * h0 * f, v1 = acc[ai][1][m][1] * h1 * f; const int j0 = wc * 16 + fq * 4;
        const f32x2* tp = (const f32x2*)(b.rope + ((size_t)pos * 64 + 2 * j0) * 2); const f32x2 a0 = tp[0], a1 = tp[2], a2 = tp[4], a3 = tp[6];
        rope4(v0, v1, (f32x4){a0[0], a0[1], a1[0], a1[1]}, (f32x4){a2[0], a2[1], a3[0], a3[1]});
        st8(qp + 128 + c0, v0, v1); } }
  }
};

struct EpiKV {
  Bufs b;
  __device__ __forceinline__ void operator()(EPI_ARGS) const {
    const int head = u.pn, rbase = u.pm * 256 + wr * 64 + fr, c0 = wc * 32 + fq * 8;
    float part[8], rs[8];
    FOR_AI_M { const int row = rbase + ai * 128 + m * 16; { const f32x4 s0 = *(const f32x4*)(b.ssq_ckv + (size_t)(b.g0 + row) * 4); rs[ai * 4 + m] = rsqrtf(((s0[0] + s0[1]) + (s0[2] + s0[3])) * (1.f / 256.f) + EPS); }
      float s = dot4(acc[ai][0][m][0]) + dot4(acc[ai][0][m][1]);
      s += __shfl_xor(s, 16); s += __shfl_xor(s, 32); part[ai * 4 + m] = s; }
    xwave_rowsum(part, wr, wc, fr, fq, scr);
    const float* gkp = b.gkp; asm volatile("" : "+s"(gkp));
    const f32x4 g0 = *(const f32x4*)(gkp + c0), g1 = *(const f32x4*)(gkp + c0 + 4);
    const int kc0 = (wc * 4 + fq) * 4; const f32x4 gr = *(const f32x4*)(gkp + 128 + kc0);
    FOR_AI_M { const int i = ai * 4 + m, row = rbase + ai * 128 + m * 16, pos = (b.g0 + row) & b.slm;
      const float r1 = rs[i], rsk = rsqrtf((r1 * r1 * part[i] + (b.ssq_kr[(size_t)(b.g0 + row) * 2] + b.ssq_kr[(size_t)(b.g0 + row) * 2 + 1])) * (1.f / 192.f) + EPS), f = r1 * rsk;
      bf16_t* kp = b.K + (size_t)row * 1536 + head * 192;
      st8(kp + c0, acc[ai][0][m][0] * g0 * f, acc[ai][0][m][1] * g1 * f);
      st8(b.V + (size_t)row * 1024 + head * 128 + c0, acc[ai][1][m][0] * r1, acc[ai][1][m][1] * r1);
      const u32x2 w = *(const u32x2*)(b.KR + (size_t)row * 64 + kc0);
      const float x0 = bflo(w.x) * gr[0], y0 = bfhi(w.x) * gr[1], x1 = bflo(w.y) * gr[2], y1 = bfhi(w.y) * gr[3];
      const f32x2* tp = (const f32x2*)(b.rope + ((size_t)pos * 64 + kc0) * 2); const f32x2 a0 = tp[0], a1 = tp[2];
      u32x2 o; o.x = cvt_pk((x0 * a0[0] - y0 * a0[1]) * rsk, (x0 * a0[1] + y0 * a0[0]) * rsk); o.y = cvt_pk((x1 * a1[0] - y1 * a1[1]) * rsk, (x1 * a1[1] + y1 * a1[0]) * rsk);
      *(u32x2*)(kp + 128 + kc0) = o; }
  }
};

template <int mode> struct EpiGate {
  Bufs b;
  __device__ __forceinline__ void operator()(EPI_ARGS) const {
    const int rbase = u.pm * 256 + wr * 64 + fr, c0 = u.pn * 256 + wc * 32 + fq * 8; const bf16_t* gate = mode ? b.GA : b.GR; bf16_t* mg = b.RV;
#pragma unroll
    for (int ai = 0; ai < 2; ++ai) {
      SBAR0();
      u32x4 gt[4][2], pv[4][2];
#pragma unroll
      for (int m = 0; m < 4; ++m)
#pragma unroll
        for (int bj = 0; bj < 2; ++bj) { const size_t idx = (size_t)(rbase + ai * 128 + m * 16) * 1024 + c0 + bj * 128; gt[m][bj] = *(const u32x4*)(gate + idx); if (mode) pv[m][bj] = *(const u32x4*)(mg + idx); }
#pragma unroll
      for (int m = 0; m < 4; ++m)
#pragma unroll
        for (int bj = 0; bj < 2; ++bj) { const size_t idx = (size_t)(rbase + ai * 128 + m * 16) * 1024 + c0 + bj * 128; const u32x4 g = gt[m][bj];
          f32x4 v0 = acc[ai][bj][m][0] * (f32x4){bflo(g.x), bfhi(g.x), bflo(g.y), bfhi(g.y)}, v1 = acc[ai][bj][m][1] * (f32x4){bflo(g.z), bfhi(g.z), bflo(g.w), bfhi(g.w)};
          if (mode) { const u32x4 p = pv[m][bj]; v0 += (f32x4){bflo(p.x), bfhi(p.x), bflo(p.y), bfhi(p.y)}; v1 += (f32x4){bflo(p.z), bfhi(p.z), bflo(p.w), bfhi(p.w)}; }
          st8(mg + idx, v0, v1); }
    }
  }
};

struct EpiOut {
  Bufs b; bool at;
  __device__ __forceinline__ void operator()(EPI_ARGS) const {
    const int rbase = u.pm * 256 + wr * 64 + fr, c0 = u.pn * 256 + wc * 32 + fq * 8;
#pragma unroll
    for (int ai = 0; ai < 2; ++ai) {
      SBAR0();
      f32x4 xv[4][2][2];
#pragma unroll
      for (int m = 0; m < 4; ++m) { const float* xr = xrow(b, b.g0 + rbase + ai * 128 + m * 16);
#pragma unroll
        for (int bj = 0; bj < 2; ++bj) { xv[m][bj][0] = *(const f32x4*)(xr + c0 + bj * 128); xv[m][bj][1] = *(const f32x4*)(xr + c0 + bj * 128 + 4); } }
#pragma unroll
      for (int m = 0; m < 4; ++m) { const int row = rbase + ai * 128 + m * 16, g = b.g0 + row; float s = 0.f;
#pragma unroll
        for (int bj = 0; bj < 2; ++bj) { const int c = c0 + bj * 128; const f32x4 v0 = acc[ai][bj][m][0] + xv[m][bj][0], v1 = acc[ai][bj][m][1] + xv[m][bj][1];
          st8(b.RG + (size_t)row * 1024 + c, v0, v1); s += dot4(v0) + dot4(v1); }
        s += __shfl_xor(s, 16); s += __shfl_xor(s, 32); if (fq == 0 && at) b.ssq_x1[(size_t)g * 16 + u.pn * 4 + wc] = s; }
    }
  }
};

struct EpiUp {
  Bufs b;
  __device__ __forceinline__ void operator()(EPI_ARGS) const {
    const int rbase = u.pm * 256 + wr * 64 + fr, c0 = u.pn * 256 + wc * 32 + fq * 8;
    FOR_AI_M { const int row = rbase + ai * 128 + m * 16; const f32x4* sp = (const f32x4*)(b.ssq_x1 + (size_t)(b.g0 + row) * 16); const f32x4 q0 = sp[0], q1 = sp[1], q2 = sp[2], q3 = sp[3];
      const float r2 = rsqrtf(((((q0[0] + q0[1]) + (q0[2] + q0[3])) + ((q1[0] + q1[1]) + (q1[2] + q1[3]))) + (((q2[0] + q2[1]) + (q2[2] + q2[3])) + ((q3[0] + q3[1]) + (q3[2] + q3[3])))) * (1.f / 1024.f) + EPS);
#pragma unroll
      for (int bj = 0; bj < 2; ++bj) st8(b.UR + (size_t)row * N_UP + c0 + bj * 128, acc[ai][bj][m][0] * r2, acc[ai][bj][m][1] * r2); }
  }
};

struct EpiDown {
  Bufs b; bool at;
  __device__ __forceinline__ void operator()(EPI_ARGS) const {
    const int rbase = u.pm * 256 + wr * 64 + fr, c0 = u.pn * 256 + wc * 32 + fq * 8;
#pragma unroll
    for (int ai = 0; ai < 2; ++ai) {
      SBAR0();
      u32x4 xv[4][2];
#pragma unroll
      for (int m = 0; m < 4; ++m)
#pragma unroll
        for (int bj = 0; bj < 2; ++bj) xv[m][bj] = *(const u32x4*)(b.RG + (size_t)(rbase + ai * 128 + m * 16) * 1024 + c0 + bj * 128);
      if (at) {
#pragma unroll
        for (int m = 0; m < 4; ++m) { float* orow = b.out + (size_t)(b.g0 + rbase + ai * 128 + m * 16) * DM;
#pragma unroll
          for (int bj = 0; bj < 2; ++bj) { const int c = c0 + bj * 128; const u32x4 p = xv[m][bj];
            *(f32x4*)(orow + c) = (f32x4){bflo(p.x), bfhi(p.x), bflo(p.y), bfhi(p.y)} + acc[ai][bj][m][0]; *(f32x4*)(orow + c + 4) = (f32x4){bflo(p.z), bfhi(p.z), bflo(p.w), bfhi(p.w)} + acc[ai][bj][m][1]; } }
      }
    }
  }
};

#define SBAR() __builtin_amdgcn_sched_barrier(0)
__device__ __forceinline__ int crow(int r, int hi) { return (r & 3) + 8 * (r >> 2) + 4 * hi; }
__device__ __forceinline__ int v_st(int k, int c) { const int kk = (k & ~0xC) | ((k & 4) << 1) | ((k & 8) >> 1); return ((kk >> 3) * 4 + (c >> 5)) * 512 + ((kk & 7) * 32 + (c & 31)) * 2; }
__device__ __forceinline__ int v_rd_base(int lane) { return ((lane & 3) << 3) | (((lane >> 2) & 3) << 6) | (((lane >> 4) & 1) << 5) | (((lane >> 5) & 1) << 8); }
constexpr int v_rd_off(int d0, int ks, int half) { return d0 * 512 + ks * 4096 + half * 2048; }
template <int OFF> __device__ __forceinline__ s16x4 tr_read(int vb) {
  s16x4 r; asm volatile("ds_read_b64_tr_b16 %0, %1 offset:%2" : "=&v"(r) : "v"(vb), "i"(OFF) : "memory"); return r;
}
#define PKLH(L, H) (bf16x8){L[0], L[1], L[2], L[3], H[0], H[1], H[2], H[3]}
template <int D0> __device__ __forceinline__ void pv_one(f32x16& od, int vb, bf16x8 pa0, bf16x8 pa1, bf16x8 pa2, bf16x8 pa3) {
  const s16x4 l0 = tr_read<v_rd_off(D0, 0, 0)>(vb), h0 = tr_read<v_rd_off(D0, 0, 1)>(vb), l1 = tr_read<v_rd_off(D0, 1, 0)>(vb), h1 = tr_read<v_rd_off(D0, 1, 1)>(vb);
  const s16x4 l2 = tr_read<v_rd_off(D0, 2, 0)>(vb), h2 = tr_read<v_rd_off(D0, 2, 1)>(vb), l3 = tr_read<v_rd_off(D0, 3, 0)>(vb), h3 = tr_read<v_rd_off(D0, 3, 1)>(vb);
  asm volatile("s_waitcnt lgkmcnt(0)" ::: "memory"); SBAR();
  od = __builtin_amdgcn_mfma_f32_32x32x16_bf16(pa0, PKLH(l0, h0), od, 0, 0, 0);
  od = __builtin_amdgcn_mfma_f32_32x32x16_bf16(pa1, PKLH(l1, h1), od, 0, 0, 0);
  od = __builtin_amdgcn_mfma_f32_32x32x16_bf16(pa2, PKLH(l2, h2), od, 0, 0, 0);
  od = __builtin_amdgcn_mfma_f32_32x32x16_bf16(pa3, PKLH(l3, h3), od, 0, 0, 0);
}
template <int D0> __device__ __forceinline__ void pv_issue(s16x4 (&t)[8], int vb) {
  t[0] = tr_read<v_rd_off(D0, 0, 0)>(vb); t[1] = tr_read<v_rd_off(D0, 0, 1)>(vb); t[2] = tr_read<v_rd_off(D0, 1, 0)>(vb); t[3] = tr_read<v_rd_off(D0, 1, 1)>(vb);
  t[4] = tr_read<v_rd_off(D0, 2, 0)>(vb); t[5] = tr_read<v_rd_off(D0, 2, 1)>(vb); t[6] = tr_read<v_rd_off(D0, 3, 0)>(vb); t[7] = tr_read<v_rd_off(D0, 3, 1)>(vb);
}
__device__ __forceinline__ void pv_mma(f32x16& od, const s16x4 (&t)[8], bf16x8 pa0, bf16x8 pa1, bf16x8 pa2, bf16x8 pa3) {
  od = __builtin_amdgcn_mfma_f32_32x32x16_bf16(pa0, PKLH(t[0], t[1]), od, 0, 0, 0);
  od = __builtin_amdgcn_mfma_f32_32x32x16_bf16(pa1, PKLH(t[2], t[3]), od, 0, 0, 0);
  od = __builtin_amdgcn_mfma_f32_32x32x16_bf16(pa2, PKLH(t[4], t[5]), od, 0, 0, 0);
  od = __builtin_amdgcn_mfma_f32_32x32x16_bf16(pa3, PKLH(t[6], t[7]), od, 0, 0, 0);
}
__device__ __forceinline__ void pv_d0(f32x16* o, int vb, bf16x8 pa0, bf16x8 pa1, bf16x8 pa2, bf16x8 pa3) {
  s16x4 ta[8], tb[8];
  pv_issue<0>(ta, vb);
  pv_issue<1>(tb, vb); asm volatile("s_waitcnt lgkmcnt(8)" ::: "memory"); SBAR(); pv_mma(o[0], ta, pa0, pa1, pa2, pa3);
  pv_issue<2>(ta, vb); asm volatile("s_waitcnt lgkmcnt(8)" ::: "memory"); SBAR(); pv_mma(o[1], tb, pa0, pa1, pa2, pa3);
  pv_issue<3>(tb, vb); asm volatile("s_waitcnt lgkmcnt(8)" ::: "memory"); SBAR(); pv_mma(o[2], ta, pa0, pa1, pa2, pa3);
  asm volatile("s_waitcnt lgkmcnt(0)" ::: "memory"); SBAR(); pv_mma(o[3], tb, pa0, pa1, pa2, pa3);
}
#define PK4(P, BASE, OUT) do { unsigned a0 = cvt_pk(P[BASE + 0], P[BASE + 1]), a1 = cvt_pk(P[BASE + 2], P[BASE + 3]);   \
    unsigned b0 = cvt_pk(P[BASE + 4], P[BASE + 5]), b1 = cvt_pk(P[BASE + 6], P[BASE + 7]);                              \
    auto r0 = __builtin_amdgcn_permlane32_swap(a0, b0, false, false); auto r1 = __builtin_amdgcn_permlane32_swap(a1, b1, false, false); \
    u32x4 w = {r0[0], r1[0], r0[1], r1[1]}; OUT = *reinterpret_cast<bf16x8*>(&w); } while (0)

namespace att {
constexpr int DQK = 192, DV = 128, NW = 8, QBLK = 32, KVBLK = 64, NQD = DQK / 16;
constexpr int LDQ = 1536, LDK = 1536, LDV = 1024, LDO = 1024;
constexpr float SCALE = 0.07216878364870323f, THR = 8.f;
constexpr int SHM_V = KVBLK * DV * 2, SHM_K = KVBLK * DQK * 2;
#define KSWZ3(row, colB) ((row) * 384 + ((colB) ^ ((((row) >> 1) & 7) << 4)))
__device__ __forceinline__ void partialSM(f32x16& p0, f32x16& p1, float& m_reg, float& alpha, bool first) {
  constexpr float THR2 = THR * 1.4426950408889634f;
  float pmax = p0[0];
#pragma unroll
  for (int r = 1; r < 16; ++r) pmax = fmaxf(pmax, p0[r]);
#pragma unroll
  for (int r = 0; r < 16; ++r) pmax = fmaxf(pmax, p1[r]);
  { auto rr = __builtin_amdgcn_permlane32_swap(__float_as_uint(pmax), __float_as_uint(pmax), false, false);
    pmax = fmaxf(__uint_as_float(rr[0]), __uint_as_float(rr[1])); }
  if (__builtin_expect(!first && __all(pmax <= THR2), 1)) { alpha = 1.f; }
  else { const float d = first ? pmax : fmaxf(pmax, 0.f); alpha = __builtin_amdgcn_exp2f(-d); m_reg += d;
#pragma unroll
    for (int r = 0; r < 16; ++r) { p0[r] -= d; p1[r] -= d; } }
#pragma unroll
  for (int r = 0; r < 16; ++r) p0[r] = __builtin_amdgcn_exp2f(p0[r]);
}
__device__ __forceinline__ void finishSM(f32x16& p0, f32x16& p1, float alpha, float& l_reg, bf16x8& pa0, bf16x8& pa1, bf16x8& pa2, bf16x8& pa3) {
#pragma unroll
  for (int r = 0; r < 16; ++r) p1[r] = __builtin_amdgcn_exp2f(p1[r]);
  float ps = 0;
#pragma unroll
  for (int r = 0; r < 16; ++r) ps += p0[r];
#pragma unroll
  for (int r = 0; r < 16; ++r) ps += p1[r];
  { auto rr = __builtin_amdgcn_permlane32_swap(__float_as_uint(ps), __float_as_uint(ps), false, false);
    ps = __uint_as_float(rr[0]) + __uint_as_float(rr[1]); }
  l_reg = l_reg * alpha + ps;
  PK4(p0, 0, pa0); PK4(p0, 8, pa1); PK4(p1, 0, pa2); PK4(p1, 8, pa3);
}
__device__ __forceinline__ void qkt(f32x16& p0, f32x16& p1, const char* Ks, const bf16x8* qr, const char* qrl, int qsw, int r32, int hi, float init) {
#pragma unroll
  for (int r = 0; r < 16; ++r) { p0[r] = init; p1[r] = init; }
#pragma unroll
  for (int d0 = 0; d0 < 8; ++d0) { int cb = (d0 * 16 + hi * 8) * 2;
    bf16x8 b0 = *reinterpret_cast<const bf16x8*>(Ks + KSWZ3(r32, cb));
    bf16x8 b1 = *reinterpret_cast<const bf16x8*>(Ks + KSWZ3(32 + r32, cb));
    p0 = __builtin_amdgcn_mfma_f32_32x32x16_bf16(b0, qr[d0], p0, 0, 0, 0);
    p1 = __builtin_amdgcn_mfma_f32_32x32x16_bf16(b1, qr[d0], p1, 0, 0, 0); }
#pragma unroll
  for (int d0 = 0; d0 < 4; ++d0) { int cb = ((8 + d0) * 16 + hi * 8) * 2;
    bf16x8 q = *reinterpret_cast<const bf16x8*>(qrl + (((d0 * 2 + hi) ^ qsw) << 4));
    bf16x8 b0 = *reinterpret_cast<const bf16x8*>(Ks + KSWZ3(r32, cb));
    bf16x8 b1 = *reinterpret_cast<const bf16x8*>(Ks + KSWZ3(32 + r32, cb));
    p0 = __builtin_amdgcn_mfma_f32_32x32x16_bf16(b0, q, p0, 0, 0, 0);
    p1 = __builtin_amdgcn_mfma_f32_32x32x16_bf16(b1, q, p1, 0, 0, 0); }
}
__device__ __forceinline__ void attn_unit(const bf16_t* __restrict__ Qb, const bf16_t* __restrict__ Kh, const bf16_t* __restrict__ Vh, bf16_t* __restrict__ Ob, int seq, char* lds, LAS unsigned char* ldsl) {
  int tid_ = threadIdx.x; asm volatile("" : "+v"(tid_));
  const int tid = tid_, wid = __builtin_amdgcn_readfirstlane(tid >> 6), lane = tid & 63, r32 = lane & 31, hi = lane >> 5;
  constexpr int OFF_K = 3 * SHM_V, OFF_WS = 3 * SHM_V + 3 * SHM_K;
  char* V_lds = lds; char* K_lds = lds + OFF_K;
  float* ws = (float*)(lds + OFF_WS) + wid * 64; float* li_l = ws; float* al_l = ws + 32;
  float m_reg = 0.f, l_reg = 0; f32x16 o[4] = {}; bf16x8 qr[8];
  const bf16_t* Qw = Qb + (long)(wid * QBLK + r32) * LDQ + hi * 8;
#pragma unroll
  for (int d0 = 0; d0 < 8; ++d0) qr[d0] = *reinterpret_cast<const bf16x8*>(Qw + d0 * 16);
  char* qrl = lds + OFF_WS + 2048 + wid * 4096 + r32 * 128;
  const int qsw = (r32 >> 1) & 7;
#pragma unroll
  for (int d0 = 0; d0 < 4; ++d0) *(bf16x8*)(qrl + (((d0 * 2 + hi) ^ qsw) << 4)) = *reinterpret_cast<const bf16x8*>(Qw + 128 + d0 * 16);
  int kof[3], vof[2];
#pragma unroll
  for (int i = 0; i < 3; ++i) { const int L = (wid * 3 + i) * 1024 + lane * 16, row = L / 384, x = L - row * 384, cb = x ^ (((row >> 1) & 7) << 4); kof[i] = row * LDK + (cb >> 1); }
#pragma unroll
  for (int i = 0; i < 2; ++i) { const int L = (wid * 2 + i) * 1024 + lane * 16, sub = L >> 9, w = L & 511, kk = (sub >> 2) * 8 + (w >> 6), c = (sub & 3) * 32 + ((w & 63) >> 1);
    const int k = (kk & ~0xC) | ((kk & 4) << 1) | ((kk & 8) >> 1); vof[i] = k * LDV + c; }
  const int vb0 = (int)(uintptr_t)V_lds + v_rd_base(lane);
#define KVDMA(t, slot) do { const bf16_t* kb_ = Kh + (long)(t) * (KVBLK * LDK); const bf16_t* vb_ = Vh + (long)(t) * (KVBLK * LDV); \
    _Pragma("unroll") for (int i_ = 0; i_ < 3; ++i_) __builtin_amdgcn_global_load_lds((const unsigned*)(kb_ + kof[i_]), (LAS unsigned*)(ldsl + OFF_K + (slot) * SHM_K + (wid * 3 + i_) * 1024), 16, 0, 0); \
    _Pragma("unroll") for (int i_ = 0; i_ < 2; ++i_) __builtin_amdgcn_global_load_lds((const unsigned*)(vb_ + vof[i_]), (LAS unsigned*)(ldsl + (slot) * SHM_V + (wid * 2 + i_) * 1024), 16, 0, 0); } while (0)
#define TILE_SYNC() do { asm volatile("s_waitcnt vmcnt(0)" ::: "memory"); __syncthreads(); } while (0)
#define RESC(a) do { if (__any((a) < 1.f)) { if (hi == 0) al_l[r32] = (a); asm volatile("s_waitcnt lgkmcnt(0)" ::: "memory"); \
    _Pragma("unroll") for (int d = 0; d < 4; ++d) _Pragma("unroll") for (int r = 0; r < 16; ++r) o[d][r] *= al_l[crow(r, hi)]; } } while (0)
  f32x16 pA0, pA1, pB0, pB1; float alA, alB; bf16x8 pa0, pa1, pa2, pa3; const int NT = seq / KVBLK;
  KVDMA(0, 0); KVDMA(1, 1); TILE_SYNC();
  qkt(pA0, pA1, K_lds, qr, qrl, qsw, r32, hi, 0.f); partialSM(pA0, pA1, m_reg, alA, true);
  int sK = 1, sV = 0, sN = 2;
#define NEXT3(x) ((x) == 2 ? 0 : (x) + 1)
  for (int j = 1; j + 1 < NT; j += 2) {
    KVDMA(j + 1, sN);
    SBAR(); qkt(pB0, pB1, K_lds + sK * SHM_K, qr, qrl, qsw, r32, hi, -m_reg);
    finishSM(pA0, pA1, alA, l_reg, pa0, pa1, pa2, pa3); SBAR();
    pv_d0(o, vb0 + sV * SHM_V, pa0, pa1, pa2, pa3); partialSM(pB0, pB1, m_reg, alB, false);
    RESC(alB); TILE_SYNC();
    sV = sK; sK = sN; sN = NEXT3(sN);
    if (j + 2 < NT) KVDMA(j + 2, sN);
    SBAR(); qkt(pA0, pA1, K_lds + sK * SHM_K, qr, qrl, qsw, r32, hi, -m_reg);
    finishSM(pB0, pB1, alB, l_reg, pa0, pa1, pa2, pa3); SBAR();
    pv_d0(o, vb0 + sV * SHM_V, pa0, pa1, pa2, pa3); partialSM(pA0, pA1, m_reg, alA, false);
    RESC(alA); TILE_SYNC();
    sV = sK; sK = sN; sN = NEXT3(sN);
  }
  SBAR(); qkt(pB0, pB1, K_lds + sK * SHM_K, qr, qrl, qsw, r32, hi, -m_reg);
  finishSM(pA0, pA1, alA, l_reg, pa0, pa1, pa2, pa3); SBAR();
  pv_d0(o, vb0 + sV * SHM_V, pa0, pa1, pa2, pa3); partialSM(pB0, pB1, m_reg, alB, false);
  RESC(alB);
  finishSM(pB0, pB1, alB, l_reg, pa0, pa1, pa2, pa3); SBAR();
  pv_d0(o, vb0 + sK * SHM_V, pa0, pa1, pa2, pa3);
  if (hi == 0) li_l[r32] = l_reg; asm volatile("s_waitcnt lgkmcnt(0)" ::: "memory");
  float rli[16];
#pragma unroll
  for (int r = 0; r < 16; ++r) rli[r] = __builtin_amdgcn_rcpf(li_l[crow(r, hi)]);
  bf16_t* Ow = Ob + (long)(wid * QBLK) * LDO;
#pragma unroll
  for (int r = 0; r < 16; ++r) { int orow = crow(r, hi);
#pragma unroll
    for (int d0 = 0; d0 < 4; ++d0) Ow[(long)orow * LDO + d0 * 32 + r32] = (bf16_t)(cvt_pk(o[d0][r] * rli[r], 0.f) & 0xffffu); }
  __syncthreads();
#undef KVDMA
#undef TILE_SYNC
#undef RESC
#undef NEXT3
}
}

#define KSWZ(row, colB) ((row) * 256 + ((colB) ^ ((((row) & 7) << 4) | ((((row) >> 3) & 1) << 7))))
__device__ __forceinline__ bf16x8 scale8(bf16x8 x, float s) {
  u32x4 w = *reinterpret_cast<u32x4*>(&x);
  u32x4 o = {cvt_pk(bflo(w.x) * s, bfhi(w.x) * s), cvt_pk(bflo(w.y) * s, bfhi(w.y) * s), cvt_pk(bflo(w.z) * s, bfhi(w.z) * s), cvt_pk(bflo(w.w) * s, bfhi(w.w) * s)};
  return *reinterpret_cast<bf16x8*>(&o);
}
__device__ __forceinline__ void stage_v_chunk(const bf16_t* Vg, char* lds, int tid) {
#pragma unroll
  for (int i = 0; i < 8; ++i) { const int p = tid + 512 * i, row = p >> 5, col = (p & 31) * 8;
    const bf16x8 v = *reinterpret_cast<const bf16x8*>(Vg + (size_t)row * 1024 + col);
    *(bf16x8*)(lds + ((row >> 6) * 2 + (col >> 7)) * 16384 + v_st(row & 63, col & 127)) = v; }
}
template <int OFF> __device__ __forceinline__ bf16x8 tr_frag(int base) { const s16x4 l = tr_read<OFF>(base), h = tr_read<OFF + 2048>(base); asm volatile("s_waitcnt lgkmcnt(0)" ::: "memory"); return PKLH(l, h); }

__device__ __forceinline__ void ret_kv_item(const Bufs& b, int item, float lgf2, float lgb2, char* lds) {
  int tid_ = threadIdx.x; asm volatile("" : "+v"(tid_));
  const int tid = tid_, wid = tid >> 6, lane = tid & 63, r32 = lane & 31, hi = lane >> 5;
  const int ci = item >> 2, h = item & 3; const size_t tok0 = (size_t)ci * 128;
  const bf16_t* Kg = b.RK + tok0 * 512 + h * 128; const bf16_t* Vg = b.RV + tok0 * 1024 + h * 256;
  stage_v_chunk(Vg, lds, tid);
#pragma unroll
  for (int i = 0; i < 4; ++i) { const int p = tid + 512 * i, row = p >> 4, col = (p & 15) * 8;
    const bf16x8 k = *reinterpret_cast<const bf16x8*>(Kg + (size_t)row * 512 + col);
    const float sf = __builtin_amdgcn_exp2f(lgf2 * (float)(127 - row)), sb = __builtin_amdgcn_exp2f(lgb2 * (float)row);
    const int off = (row >> 6) * 16384 + v_st(row & 63, col);
    *(bf16x8*)(lds + 65536 + off) = scale8(k, sf); *(bf16x8*)(lds + 98304 + off) = scale8(k, sb); }
  __syncthreads();
  const int rb = v_rd_base(lane), lb = (int)(uintptr_t)lds;
  const int vbase = lb + (wid >> 2) * 16384 + rb + (wid & 3) * 512;
#define R1_STEP(T, KS, KOFF) do { const bf16x8 a = tr_frag<v_rd_off(0, KS, 0)>(vbase + (T) * 32768); \
    { const int kf = lb + (KOFF) + (T) * 16384 + rb; \
      const bf16x8 f0 = tr_frag<v_rd_off(0, KS, 0)>(kf), f1 = tr_frag<v_rd_off(1, KS, 0)>(kf), f2 = tr_frag<v_rd_off(2, KS, 0)>(kf), f3 = tr_frag<v_rd_off(3, KS, 0)>(kf); \
      aF[0] = __builtin_amdgcn_mfma_f32_32x32x16_bf16(a, f0, aF[0], 0, 0, 0); aF[1] = __builtin_amdgcn_mfma_f32_32x32x16_bf16(a, f1, aF[1], 0, 0, 0); \
      aF[2] = __builtin_amdgcn_mfma_f32_32x32x16_bf16(a, f2, aF[2], 0, 0, 0); aF[3] = __builtin_amdgcn_mfma_f32_32x32x16_bf16(a, f3, aF[3], 0, 0, 0); } SBAR(); } while (0)
#pragma unroll
  for (int dir = 0; dir < 2; ++dir) {
    f32x16 aF[4] = {};
    if (dir == 0) { R1_STEP(0, 0, 65536); R1_STEP(0, 1, 65536); R1_STEP(0, 2, 65536); R1_STEP(0, 3, 65536); R1_STEP(1, 0, 65536); R1_STEP(1, 1, 65536); R1_STEP(1, 2, 65536); R1_STEP(1, 3, 65536); }
    else { R1_STEP(0, 0, 98304); R1_STEP(0, 1, 98304); R1_STEP(0, 2, 98304); R1_STEP(0, 3, 98304); R1_STEP(1, 0, 98304); R1_STEP(1, 1, 98304); R1_STEP(1, 2, 98304); R1_STEP(1, 3, 98304); }
    bf16_t* od = b.KV + (size_t)item * 65536 + dir * 32768;
#pragma unroll
    for (int n0 = 0; n0 < 4; ++n0)
#pragma unroll
      for (int r = 0; r < 16; ++r) od[(32 * wid + crow(r, hi)) * 128 + 32 * n0 + r32] = (bf16_t)(cvt_pk_s(aF[n0][r], 0.f) & 0xffffu);
    SBAR();
  }
#undef R1_STEP
  __syncthreads();
}

__device__ __forceinline__ float lg2_of(const float* dec, int h);
__device__ __forceinline__ void ret_scan(const Bufs& b, int nseq, int NC, const float* dec_f, const float* dec_b, int gtid, int gthreads) {
  const int nvec = nseq * 32768;
  for (int v = gtid; v < nvec; v += gthreads) {
    const int e8 = v & 4095, dir = (v >> 12) & 1, h = (v >> 13) & 3, s = v >> 15;
    const float decay = __builtin_amdgcn_exp2f(lg2_of(dir ? dec_b : dec_f, h) * 128.f);
    float st[8];
#pragma unroll
    for (int e = 0; e < 8; ++e) st[e] = 0.f;
    for (int step = 0; step < NC; step += 4) {
      u32x4 kv[4]; bf16_t* ptr[4];
#pragma unroll
      for (int q = 0; q < 4; ++q) { const int c = dir ? NC - 1 - (step + q) : step + q; ptr[q] = b.KV + ((size_t)(((s * NC + c) * 4 + h) * 2 + dir)) * 32768 + e8 * 8; kv[q] = *(const u32x4*)ptr[q]; }
#pragma unroll
      for (int q = 0; q < 4; ++q) {
        u32x4 o = {cvt_pk(st[0], st[1]), cvt_pk(st[2], st[3]), cvt_pk(st[4], st[5]), cvt_pk(st[6], st[7])}; *(u32x4*)ptr[q] = o;
        st[0] = st[0] * decay + bflo(kv[q].x); st[1] = st[1] * decay + bfhi(kv[q].x); st[2] = st[2] * decay + bflo(kv[q].y); st[3] = st[3] * decay + bfhi(kv[q].y);
        st[4] = st[4] * decay + bflo(kv[q].z); st[5] = st[5] * decay + bfhi(kv[q].z); st[6] = st[6] * decay + bflo(kv[q].w); st[7] = st[7] * decay + bfhi(kv[q].w); }
    }
  }
}

__device__ __forceinline__ void qkt128(f32x16& p0, f32x16& p1, const char* Ks, const bf16x8* qr, int r32, int hi) {
  p0 = f32x16{}; p1 = f32x16{};
#pragma unroll
  for (int d0 = 0; d0 < 8; ++d0) { int cb = (d0 * 16 + hi * 8) * 2;
    bf16x8 b0 = *reinterpret_cast<const bf16x8*>(Ks + KSWZ(r32, cb));
    bf16x8 b1 = *reinterpret_cast<const bf16x8*>(Ks + KSWZ(32 + r32, cb));
    p0 = __builtin_amdgcn_mfma_f32_32x32x16_bf16(b0, qr[d0], p0, 0, 0, 0);
    p1 = __builtin_amdgcn_mfma_f32_32x32x16_bf16(b1, qr[d0], p1, 0, 0, 0); }
}
__device__ __forceinline__ void ret_out_item(const Bufs& b, int item, float lgf2, float lgb2, const float* gn_g, char* lds) {
  int tid_ = threadIdx.x; asm volatile("" : "+v"(tid_));
  const int tid = tid_, wid = tid >> 6, lane = tid & 63, r32 = lane & 31, hi = lane >> 5, wr = wid & 3, wc = wid >> 2;
  const int ci = item >> 2, h = item & 3; const size_t tok0 = (size_t)ci * 128;
  const bf16_t* Qg = b.RQ + tok0 * 512 + h * 128; const bf16_t* Kg = b.RK + tok0 * 512 + h * 128; const bf16_t* Vg = b.RV + tok0 * 1024 + h * 256;
  const bf16_t* Sf = b.KV + (size_t)item * 65536; const bf16_t* Sb = Sf + 32768;
  char* K_lds = lds; char* V_lds = lds + 32768;
#pragma unroll
  for (int i = 0; i < 4; ++i) { const int p = tid + 512 * i, row = p >> 4, col = (p & 15) * 8;
    *(bf16x8*)(K_lds + KSWZ(row, col * 2)) = *reinterpret_cast<const bf16x8*>(Kg + (size_t)row * 512 + col); }
  stage_v_chunk(Vg, V_lds, tid);
  bf16x8 qr[8];
  { const bf16_t* Qw = Qg + (size_t)(wr * 32 + r32) * 512 + hi * 8;
#pragma unroll
    for (int d0 = 0; d0 < 8; ++d0) qr[d0] = *reinterpret_cast<const bf16x8*>(Qw + d0 * 16); }
  __syncthreads();
  f32x16 o[4] = {};
  const int irow = wr * 32 + r32;
#pragma unroll
  for (int t = 0; t < 2; ++t) {
    f32x16 p0, p1; qkt128(p0, p1, K_lds + t * 16384, qr, r32, hi);
#pragma unroll
    for (int r = 0; r < 16; ++r) { const int j0 = 64 * t + crow(r, hi), d0_ = irow - j0, d1_ = d0_ - 32;
      p0[r] *= __builtin_amdgcn_exp2f(d0_ >= 0 ? lgf2 * (float)d0_ : lgb2 * (float)(-d0_));
      p1[r] *= __builtin_amdgcn_exp2f(d1_ >= 0 ? lgf2 * (float)d1_ : lgb2 * (float)(-d1_)); }
    bf16x8 pa0, pa1, pa2, pa3; PK4(p0, 0, pa0); PK4(p0, 8, pa1); PK4(p1, 0, pa2); PK4(p1, 8, pa3);
    pv_d0(o, (int)(uintptr_t)V_lds + (t * 2 + wc) * 16384 + v_rd_base(lane), pa0, pa1, pa2, pa3);
    SBAR();
  }
  __syncthreads();
#pragma unroll
  for (int i = 0; i < 8; ++i) { const int p = tid + 512 * i, row = p >> 4, col = (p & 15) * 8;
    *(bf16x8*)(lds + KSWZ(row, col * 2)) = *reinterpret_cast<const bf16x8*>(Sf + (size_t)row * 128 + col);
    *(bf16x8*)(lds + 65536 + KSWZ(row, col * 2)) = *reinterpret_cast<const bf16x8*>(Sb + (size_t)row * 128 + col); }
  const float qdf = __builtin_amdgcn_exp2f(lgf2 * (float)(irow + 1)), qdb = __builtin_amdgcn_exp2f(lgb2 * (float)(128 - irow));
  __syncthreads();
#pragma unroll
  for (int s = 0; s < 8; ++s) { const bf16x8 af = scale8(qr[s], qdf), ab = scale8(qr[s], qdb); const int cb = (s * 16 + hi * 8) * 2;
#pragma unroll
    for (int d = 0; d < 4; ++d) { const int srow = 128 * wc + 32 * d + r32;
      const bf16x8 bf = *reinterpret_cast<const bf16x8*>(lds + KSWZ(srow, cb)), bb = *reinterpret_cast<const bf16x8*>(lds + 65536 + KSWZ(srow, cb));
      o[d] = __builtin_amdgcn_mfma_f32_32x32x16_bf16(af, bf, o[d], 0, 0, 0);
      o[d] = __builtin_amdgcn_mfma_f32_32x32x16_bf16(ab, bb, o[d], 0, 0, 0); }
    SBAR(); }
  __syncthreads();
  float* ol = (float*)lds;
#pragma unroll
  for (int d = 0; d < 4; ++d)
#pragma unroll
    for (int r = 0; r < 16; ++r) ol[(wr * 32 + crow(r, hi)) * 260 + wc * 128 + d * 32 + r32] = o[d][r];
  __syncthreads();
  { const int row = tid >> 2, q = tid & 3; const float* rp = ol + row * 260 + q * 8;
    f32x4 x[16]; float s = 0.f;
#pragma unroll
    for (int k = 0; k < 8; ++k) { x[2 * k] = *(const f32x4*)(rp + 32 * k); x[2 * k + 1] = *(const f32x4*)(rp + 32 * k + 4); s += (x[2 * k][0] + x[2 * k][1]) + (x[2 * k][2] + x[2 * k][3]) + (x[2 * k + 1][0] + x[2 * k + 1][1]) + (x[2 * k + 1][2] + x[2 * k + 1][3]); }
    s += __shfl_xor(s, 1); s += __shfl_xor(s, 2); const float mu = s * (1.f / 256.f); float v = 0.f;
#pragma unroll
    for (int k = 0; k < 16; ++k) { x[k] = x[k] - mu; v += dot4(x[k]); }
    v += __shfl_xor(v, 1); v += __shfl_xor(v, 2); const float rstd = rsqrtf(v * (1.f / 256.f) + EPS);
    const size_t gofs = (tok0 + row) * 1024 + h * 256 + q * 8; const float* gp = gn_g + h * 256 + q * 8;
#pragma unroll
    for (int k = 0; k < 8; ++k) { f32x4 ga, gb; ld8(b.RG + gofs + 32 * k, ga, gb); const f32x4 w0 = *(const f32x4*)(gp + 32 * k), w1 = *(const f32x4*)(gp + 32 * k + 4);
      st8(b.URET + gofs + 32 * k, x[2 * k] * rstd * w0 * ga, x[2 * k + 1] * rstd * w1 * gb); } }
  __syncthreads();
}

__device__ __forceinline__ int src_col(int mat, int n) {
  if (mat == 0) {
    if (n < 1024) { const int base = n & ~127, hc = n & 127; return base + ((hc & 1) ? (hc >> 1) + 64 : (hc >> 1)); }
    if (n < 3072) return n;
    if (n < 4096) return 3776 + (n - 3072);
    if (n < 5120) return 4800 + (n - 4096);
    if (n < 5504) return 3072 + (n - 5120);
    if (n < 5568) { const int kc = n - 5504; return 3712 + ((kc & 1) ? (kc >> 1) + 32 : (kc >> 1)); }
    if (n < 5632) return -1;
    return 3456 + (n - 5632);
  }
  if (mat == 1) { const int head = n >> 8, hc = n & 255; if (hc < 128) return head * 192 + hc; if (hc < 192) { const int kc = hc - 128; return head * 192 + 128 + ((kc & 1) ? (kc >> 1) + 32 : (kc >> 1)); } return -1; }
  return n;
}
__device__ __forceinline__ void prep_tile(const float* W, int K, int Nsrc, const float* gain, bf16_t* Bt, int mat, int n0, int k0, float* scr, int tid) {
  const int tx = tid & 63, ty = tid >> 6; const int src = src_col(mat, n0 + tx);
#pragma unroll
  for (int kk = ty; kk < 64; kk += 8) { float v = 0.f; if (src >= 0) { v = W[(size_t)(k0 + kk) * Nsrc + src]; if (gain) v *= gain[k0 + kk]; } scr[kk * 65 + tx] = v; }
  __syncthreads();
  { const int n = tid >> 3, kq = (tid & 7) * 8; const float* s = scr + kq * 65 + n;
    u32x4 o = {cvt_pk(s[0], s[65]), cvt_pk(s[130], s[195]), cvt_pk(s[260], s[325]), cvt_pk(s[390], s[455])};
    *(u32x4*)(Bt + (size_t)(n0 + n) * K + k0 + kq) = o; }
  __syncthreads();
}
__device__ __forceinline__ void h1_rows(const Bufs& b, const float* gmix, int CH, int gw, int ngw_, int lane_) {
  int lane = lane_; asm volatile("" : "+v"(lane)); int ngw = ngw_; asm volatile("" : "+s"(ngw));
  for (int r = gw * 4; r < CH; r += ngw * 4) {
    f32x4 v[4][4]; float s[4];
#pragma unroll
    for (int q = 0; q < 4; ++q) { const f32x4* xq = (const f32x4*)xrow(b, b.g0 + r + q) + lane;
#pragma unroll
      for (int j = 0; j < 4; ++j) v[q][j] = xq[64 * j]; }
#pragma unroll
    for (int q = 0; q < 4; ++q) { s[q] = 0.f;
#pragma unroll
      for (int j = 0; j < 4; ++j) s[q] += dot4(v[q][j]); }
#pragma unroll
    for (int o = 1; o < 64; o <<= 1) {
#pragma unroll
      for (int q = 0; q < 4; ++q) s[q] += __shfl_xor(s[q], o); }
#pragma unroll
    for (int q = 0; q < 4; ++q) { const float rs = rsqrtf(s[q] * (1.f / 1024.f) + EPS); u32x2* oq = (u32x2*)(b.H1O + (size_t)(r + q) * 1024) + lane;
#pragma unroll
      for (int j = 0; j < 4; ++j) { const f32x4 g = ((const f32x4*)gmix)[lane + 64 * j]; const f32x4 y = v[q][j] * rs * g; u32x2 w = {cvt_pk(y[0], y[1]), cvt_pk(y[2], y[3])}; oq[64 * j] = w; } } }
}
__device__ __forceinline__ void conv_gate(const Bufs& b, const float* cw, const float* cbias, int CH, int bid, int nb, int tid) {
  if (tid >= 352) return;
  const int c = tid * 8;
  float w[2][3][8], bs[2][8];
#pragma unroll
  for (int hf = 0; hf < 2; ++hf) {
#pragma unroll
    for (int k = 0; k < 3; ++k) { const f32x4 a = *(const f32x4*)(cw + (size_t)k * N_UP + hf * DFF + c), d = *(const f32x4*)(cw + (size_t)k * N_UP + hf * DFF + c + 4);
#pragma unroll
      for (int e = 0; e < 4; ++e) { w[hf][k][e] = a[e]; w[hf][k][4 + e] = d[e]; } }
    const f32x4 a = *(const f32x4*)(cbias + hf * DFF + c), d = *(const f32x4*)(cbias + hf * DFF + c + 4);
#pragma unroll
    for (int e = 0; e < 4; ++e) { bs[hf][e] = a[e]; bs[hf][4 + e] = d[e]; } }
  for (int strip = bid; strip < CH / 8; strip += nb) {
    const int r0 = strip * 8; const int pos0 = (b.g0 + r0) & b.slm;
    u32x4 raw[2][10];
    const bool hp = pos0 > 0, hn = (pos0 + 8) <= b.slm;
#pragma unroll
    for (int hf = 0; hf < 2; ++hf) {
      const bf16_t* base = b.UR + (size_t)r0 * N_UP + hf * DFF + c;
      raw[hf][0] = hp ? *(const u32x4*)(base - N_UP) : (u32x4){0u, 0u, 0u, 0u};
#pragma unroll
      for (int i = 0; i < 8; ++i) raw[hf][1 + i] = *(const u32x4*)(base + (size_t)i * N_UP);
      raw[hf][9] = hn ? *(const u32x4*)(base + (size_t)8 * N_UP) : (u32x4){0u, 0u, 0u, 0u};
    }
#pragma unroll
    for (int i = 0; i < 8; ++i) {
      float ua[8], ub[8];
#pragma unroll
      for (int e = 0; e < 8; ++e) { ua[e] = bs[0][e]; ub[e] = bs[1][e]; }
#pragma unroll
      for (int k = 0; k < 3; ++k) { const u32x4 xa = raw[0][i + k], xb = raw[1][i + k];
        const float fa[8] = {bflo(xa.x), bfhi(xa.x), bflo(xa.y), bfhi(xa.y), bflo(xa.z), bfhi(xa.z), bflo(xa.w), bfhi(xa.w)};
        const float fb[8] = {bflo(xb.x), bfhi(xb.x), bflo(xb.y), bfhi(xb.y), bflo(xb.z), bfhi(xb.z), bflo(xb.w), bfhi(xb.w)};
#pragma unroll
        for (int e = 0; e < 8; ++e) { ua[e] += fa[e] * w[0][k][e]; ub[e] += fb[e] * w[1][k][e]; } }
      f32x4 y0, y1;
#pragma unroll
      for (int e = 0; e < 4; ++e) { y0[e] = ua[e] * sigm(ua[e]) * ub[e]; y1[e] = ua[4 + e] * sigm(ua[4 + e]) * ub[4 + e]; }
      st8(b.G + (size_t)(r0 + i) * DFF + c, y0, y1);
    }
  }
}


#define XB_TMO      128
#define XB_XCNT(j)  (256  + 64 * (j))
#define XB_XSUB(j)  (1280 + 64 * (j))
#define XB_XGEN(j)  (2304 + 64 * (j))
#define XB_TOP      3328
#define XB_TOPGEN   3392
#define XCD_BAR_WORDS 3456
#define XB_SPIN_CAP (1u << 18)
__device__ __forceinline__ unsigned xb_ld(unsigned* p)              { return __hip_atomic_load(p, __ATOMIC_RELAXED, __HIP_MEMORY_SCOPE_AGENT); }
__device__ __forceinline__ unsigned xb_add(unsigned* p, unsigned v) { return __hip_atomic_fetch_add(p, v, __ATOMIC_RELAXED, __HIP_MEMORY_SCOPE_AGENT); }
__device__ __forceinline__ unsigned xb_xcc_id() { return (unsigned)__builtin_amdgcn_s_getreg((3 << 11) | 20) & 0xFu; }
#define XB_SPIN(cond, bar) do { unsigned _sp = 0; while (cond) { __builtin_amdgcn_s_sleep(1); \
    if ((++_sp & 255u) == 0u) { if (xb_ld(&(bar)[XB_TMO])) break; if (_sp > XB_SPIN_CAP) { atomicAdd(&(bar)[XB_TMO], 1u); break; } } } } while (0)
struct XcdBarrier { unsigned* bar; unsigned x; volatile LAS unsigned* st; };
__device__ __forceinline__ XcdBarrier xcd_barrier_post(unsigned* bar, volatile LAS unsigned* st) {
  XcdBarrier b; b.bar = bar; b.x = xb_xcc_id(); b.st = st;
  if (threadIdx.x == 0) (void)xb_add(&bar[XB_XCNT(b.x)], 1u);
  return b;
}
__device__ __forceinline__ void xcd_barrier_complete(unsigned* bar, unsigned x, unsigned& nloc, unsigned& nx) {
  const unsigned G = gridDim.x * gridDim.y * gridDim.z;
  unsigned sum, cnt, mine, sp = 0u;
  for (;;) {
    sum = 0u; cnt = 0u; mine = 0u;
#pragma unroll
    for (unsigned j = 0; j < 16; ++j) { const unsigned c = xb_ld(&bar[XB_XCNT(j)]); sum += c; cnt += (c > 0u) ? 1u : 0u; mine = (j == x) ? c : mine; }
    if (sum == G) break;
    __builtin_amdgcn_s_sleep(1);
    if ((++sp & 255u) == 0u) { if (xb_ld(&bar[XB_TMO])) break; if (sp > XB_SPIN_CAP) { atomicAdd(&bar[XB_TMO], 1u); break; } }
  }
  nloc = mine > 0u ? mine : 1u; nx = cnt > 0u ? cnt : 1u;
}
__device__ __forceinline__ void xcd_barrier(const XcdBarrier& b) {
  asm volatile("s_waitcnt vmcnt(0)" ::: "memory");
  __syncthreads();
  if (threadIdx.x == 0) {
    unsigned* bar = b.bar;
    __builtin_amdgcn_s_waitcnt(0);
    unsigned nloc = b.st[0], nx = b.st[1];
    if (nloc == 0u) { xcd_barrier_complete(bar, b.x, nloc, nx); b.st[0] = nloc; b.st[1] = nx; }
    const unsigned old = xb_add(&bar[XB_XSUB(b.x)], 1u);
    const unsigned gen = old / nloc;
    if (old + 1u == (gen + 1u) * nloc) {
      __builtin_amdgcn_fence(__ATOMIC_RELEASE, "agent");
      asm volatile("s_waitcnt vmcnt(0)" ::: "memory");
      const unsigned og = xb_add(&bar[XB_TOP], 1u);
      const unsigned tg = og / nx;
      if (og + 1u == (tg + 1u) * nx) xb_add(&bar[XB_TOPGEN], 1u);
      else XB_SPIN(xb_ld(&bar[XB_TOPGEN]) == tg, bar);
      __builtin_amdgcn_fence(__ATOMIC_ACQUIRE, "agent");
      xb_add(&bar[XB_XGEN(b.x)], 1u);
      asm volatile("s_waitcnt vmcnt(0)" ::: "memory");
    } else {
      XB_SPIN(xb_ld(&bar[XB_XGEN(b.x)]) == gen, bar);
      __builtin_amdgcn_fence(__ATOMIC_ACQUIRE, "agent");
      asm volatile("s_waitcnt vmcnt(0)" ::: "memory");
    }
  }
  __syncthreads();
}

typedef const __attribute__((address_space(4))) Args* KArgsP;
__device__ __forceinline__ KArgsP kargs() { KArgsP p = (KArgsP)__builtin_amdgcn_kernarg_segment_ptr(); asm volatile("" : "+s"(p)); return p; }
template <int CHT> __device__ __forceinline__ Bufs make_bufs(KArgsP ap, int chunk) {
  Bufs b; unsigned char* ws = ap->ws; asm volatile("" : "+s"(ws)); unsigned char* cb = ws + WS_PERM_END; constexpr size_t CH = (size_t)CHT;
  b.H1O = (bf16_t*)(cb + PT_H1O * CH); b.RG = (bf16_t*)(cb + PT_RG * CH); b.RQ = (bf16_t*)(cb + PT_RQ * CH); b.RK = (bf16_t*)(cb + PT_RK * CH); b.RV = (bf16_t*)(cb + PT_RV * CH);
  b.GR = (bf16_t*)(cb + PT_GR * CH); b.GA = (bf16_t*)(cb + PT_GA * CH); b.CQ = (bf16_t*)(cb + PT_CQ * CH); b.CKV = (bf16_t*)(cb + PT_CKV * CH); b.KR = (bf16_t*)(cb + PT_KR * CH);
  b.Q = (bf16_t*)(cb + PT_Q * CH); b.K = (bf16_t*)(cb + PT_K * CH); b.V = (bf16_t*)(cb + PT_V * CH); b.URET = (bf16_t*)(cb + PT_URET * CH); b.KV = (bf16_t*)(cb + PT_KV * CH);
  b.UR = (bf16_t*)(cb + PT_UR * CH); b.G = (bf16_t*)(cb + PT_G * CH);
  b.rope = (const float*)(ws + WS_ROPE); float* sq = (float*)(ws + WS_SSQ); b.ssq_cq = sq; b.ssq_ckv = sq + 8 * (size_t)TT; b.ssq_kr = sq + 12 * (size_t)TT; b.ssq_x1 = sq + 14 * (size_t)TT;
  b.gqp = (const float*)(ws + WS_GP); b.gkp = b.gqp + 256;
  b.xp = ap->in[0]; b.xs = ap->in[1]; b.out = ap->out; b.g0 = chunk * CHT; b.slm = (b.g0 < NP) ? 4095 : 8191;
  return b;
}

__device__ __forceinline__ float lg2_of(const float* dec, int h) { return -log1pf(__expf(-dec[h])) * 1.4426950408889634f; }
template <int CH>
__global__ void __launch_bounds__(512, 2) fwd_kernel(Args a) {
  extern __shared__ __attribute__((aligned(16))) unsigned char lds_raw[];
  LAS unsigned char* lds = (LAS unsigned char*)lds_raw;
  char* ldsg = (char*)lds_raw;
  const int bid = blockIdx.x, G = gridDim.x;
  constexpr int nchunk = TT / CH;
  volatile LAS unsigned* bst = (volatile LAS unsigned*)(lds + LDS_BYTES - 16);
  if (threadIdx.x == 0) { bst[0] = 0u; bst[1] = 0u; }
  __syncthreads();
  XcdBarrier xbar; xbar.bar = nullptr; xbar.x = 0; xbar.st = bst;
#define PHASE_BEGIN(do_it) { for (int rs_ = 0; rs_ < DUP_SYNC; ++rs_) { XcdBarrier xb_ = xbar; xb_.bar = (unsigned*)(kargs()->ws + WS_BAR); xcd_barrier(xb_); } do_it = true; }
#define TIDS int tid = threadIdx.x; asm volatile("" : "+v"(tid)); const int lane = tid & 63, wid = tid >> 6; (void)lane; (void)wid
#define WSL unsigned char* ws = kargs()->ws; asm volatile("" : "+s"(ws))
#define WT(off) ((bf16_t*)(ws + (off)))
  bool run;
  run = true;
  if (run && PM(0)) for (int rep_ = 0; rep_ < DUP_P0; ++rep_) {
    TIDS; WSL; const int gtid = bid * 512 + tid, gthreads = G * 512;
    {
      const int T0 = 92 * 16, T1 = T0 + 32 * 6, T2 = T1 + 32 * 4, T3 = T2 + 256, T4 = T3 + 256, T5 = T4 + 256, T6 = T5 + 88 * 16, T7 = T6 + 16 * 44;
      for (int t = bid; t < T7; t += G) {
        if (t < T0) { prep_tile(kargs()->in[3], 1024, 5824, nullptr, WT(WS_WIN), 0, (t / 16) * 64, (t % 16) * 64, (float*)ldsg, tid); }
        else if (t < T1) { const int q = t - T0; prep_tile(kargs()->in[9], 384, 1536, kargs()->in[8], WT(WS_WUQ), 1, (q / 6) * 64, (q % 6) * 64, (float*)ldsg, tid); }
        else if (t < T2) { const int q = t - T1; prep_tile(kargs()->in[11], 256, 2048, kargs()->in[10], WT(WS_WUKV), 2, (q / 4) * 64, (q % 4) * 64, (float*)ldsg, tid); }
        else if (t < T3) { const int q = t - T2; prep_tile(kargs()->in[7], 1024, 1024, nullptr, WT(WS_WRO), 2, (q / 16) * 64, (q % 16) * 64, (float*)ldsg, tid); }
        else if (t < T4) { const int q = t - T3; prep_tile(kargs()->in[14], 1024, 1024, nullptr, WT(WS_WMO), 2, (q / 16) * 64, (q % 16) * 64, (float*)ldsg, tid); }
        else if (t < T5) { const int q = t - T4; prep_tile(kargs()->in[15], 1024, 1024, nullptr, WT(WS_WOUT), 2, (q / 16) * 64, (q % 16) * 64, (float*)ldsg, tid); }
        else if (t < T6) { const int q = t - T5; prep_tile(kargs()->in[17], 1024, N_UP, kargs()->in[16], WT(WS_WUP), 2, (q / 16) * 64, (q % 16) * 64, (float*)ldsg, tid); }
        else { const int q = t - T6; prep_tile(kargs()->in[20], DFF, 1024, nullptr, WT(WS_WDN), 2, (q / 44) * 64, (q % 44) * 64, (float*)ldsg, tid); }
      }
    }
    { float* rope = (float*)(ws + WS_ROPE);
      for (int i = gtid; i < 8192 * 64; i += gthreads) { const int pos = i >> 6, fi = i & 63;
        const double inv = exp2(-(double)fi * (13.287712379549449 / 64.0)); double rev = (double)pos * inv * 0.15915494309189535; rev -= floor(rev);
        const float rf = (float)rev; rope[2 * i] = __builtin_amdgcn_cosf(rf); rope[2 * i + 1] = __builtin_amdgcn_sinf(rf); } }
    if (bid == 0) { unsigned* bw = (unsigned*)(ws + WS_BAR); for (int i = tid; i < 4096; i += 512) bw[i] = 0u; }
    if (bid == 0 && tid < 256) { float* gp = (float*)(ws + WS_GP); const int c = tid; const float *g_qn = kargs()->in[12], *g_kn = kargs()->in[13];
      float q, k; if (c < 128) { q = g_qn[c]; k = g_kn[c]; } else if (c < 192) { const int kc = c - 128, d = (kc & 1) ? (kc >> 1) + 32 : (kc >> 1); q = g_qn[128 + d]; k = g_kn[128 + d]; } else { q = 0.f; k = 0.f; }
      gp[c] = q; gp[256 + c] = k; }
    { const Bufs b = make_bufs<CH>(kargs(), 0); h1_rows(b, kargs()->in[2], CH, bid * 8 + wid, G * 8, lane); }
  }
  cg::this_grid().sync();
  { XcdBarrier p_ = xcd_barrier_post((unsigned*)(kargs()->ws + WS_BAR), bst); xbar.x = p_.x; }
  for (int chunk = 0; chunk < nchunk; ++chunk) {
    const int SL = (chunk * CH < NP) ? 4096 : 8192, nseq = CH / SL, NC = SL / 128;
#define MKB const Bufs b = make_bufs<CH>(kargs(), chunk)
    PHASE_BEGIN(run);
    if (run && PM(1)) for (int rep_ = 0; rep_ < DUP_P1; ++rep_) { MKB; WSL; pg8::Gemm g{b.H1O, WT(WS_WIN), CH, N_IN, 1024, 1024}; pg8::StaticOrder S; S.init(CH, N_IN, G, bid); EpiIn E{b, rep_ == 0}; pg8::gemm_phase(lds, g, S, E); }
    PHASE_BEGIN(run);
    if (run && PM(2)) {
      for (int rep_ = 0; rep_ < DUP_P2G; ++rep_) {
      if (PM(10)) { MKB; WSL; pg8::Gemm g{b.CQ, WT(WS_WUQ), CH, 2048, 384, 384}; pg8::StaticOrder S; S.init(CH, 2048, G, bid); EpiQ E{b}; pg8::gemm_phase(lds, g, S, E); }
      if (PM(11)) { MKB; WSL; pg8::Gemm g{b.CKV, WT(WS_WUKV), CH, 2048, 256, 256}; pg8::StaticOrder S; S.init(CH, 2048, G, bid); EpiKV E{b}; pg8::gemm_phase(lds, g, S, E); }
      }
      for (int rep_ = 0; rep_ < DUP_R1; ++rep_)
      if (PM(12)) for (int it = bid; it < CH / 32; it += G) { MKB; const int h = it & 3; ret_kv_item(b, it, lg2_of(kargs()->in[4], h), lg2_of(kargs()->in[5], h), ldsg); }
    }
    PHASE_BEGIN(run);
    if (run && PM(3)) {
      if (PM(13)) { MKB; TIDS; ret_scan(b, nseq, NC, kargs()->in[4], kargs()->in[5], bid * 512 + tid, G * 512); }
      const int vb = (G % 8 == 0) ? (bid % 8) * (G / 8) + bid / 8 : bid;
      const int nqb = SL / 256, nunits = nseq * 8 * nqb;
      for (int rep_ = 0; rep_ < DUP_ATTN; ++rep_)
      if (PM(14)) for (int uidx = vb; uidx < nunits; uidx += G) { MKB; const int qb = uidx % nqb, hh = (uidx / nqb) & 7, s = uidx / (nqb * 8);
        const size_t t0 = (size_t)s * SL;
        att::attn_unit(b.Q + (t0 + (size_t)qb * 256) * 1536 + hh * 192, b.K + t0 * 1536 + hh * 192, b.V + t0 * 1024 + hh * 128, b.H1O + (t0 + (size_t)qb * 256) * 1024 + hh * 128, SL, ldsg, lds); }
    }
    PHASE_BEGIN(run);
    if (run && PM(4)) { for (int rep_ = 0; rep_ < DUP_R3; ++rep_) for (int it = bid; it < CH / 32; it += G) { MKB; const int h = it & 3; ret_out_item(b, it, lg2_of(kargs()->in[4], h), lg2_of(kargs()->in[5], h), kargs()->in[6], ldsg); } }
    PHASE_BEGIN(run);
    if (run && PM(5)) for (int rep_ = 0; rep_ < DUP_P5; ++rep_) {
      { MKB; WSL; pg8::Gemm g{b.URET, WT(WS_WRO), CH, 1024, 1024, 1024}; pg8::StaticOrder S; S.init(CH, 1024, G, bid); EpiGate<0> E{b}; pg8::gemm_phase(lds, g, S, E); }
      { MKB; WSL; pg8::Gemm g{b.H1O, WT(WS_WMO), CH, 1024, 1024, 1024}; pg8::StaticOrder S; S.init(CH, 1024, G, bid); EpiGate<1> E{b}; pg8::gemm_phase(lds, g, S, E); }
    }
    PHASE_BEGIN(run);
    if (run && PM(6)) for (int rep_ = 0; rep_ < DUP_P69; ++rep_) { MKB; WSL; pg8::Gemm g{b.RV, WT(WS_WOUT), CH, 1024, 1024, 1024}; pg8::StaticOrder S; S.init(CH, 1024, G, bid); EpiOut E{b, rep_ == 0}; pg8::gemm_phase(lds, g, S, E); }
    PHASE_BEGIN(run);
    if (run && PM(7)) for (int rep_ = 0; rep_ < DUP_P7; ++rep_) { MKB; WSL; pg8::Gemm g{b.RG, WT(WS_WUP), CH, N_UP, 1024, 1024}; pg8::StaticOrder S; S.init(CH, N_UP, G, bid); EpiUp E{b}; pg8::gemm_phase(lds, g, S, E); }
    PHASE_BEGIN(run);
    if (run && PM(8)) for (int rep_ = 0; rep_ < DUP_P8; ++rep_) { MKB; TIDS; conv_gate(b, kargs()->in[18], kargs()->in[19], CH, bid, G, tid); }
    PHASE_BEGIN(run);
    if (run && PM(9)) {
      for (int rep_ = 0; rep_ < DUP_P69; ++rep_) { MKB; WSL; pg8::Gemm g{b.G, WT(WS_WDN), CH, 1024, DFF, DFF}; pg8::StaticOrder S; S.init(CH, 1024, G, bid); EpiDown E{b, rep_ == 0}; pg8::gemm_phase(lds, g, S, E); }
      if (chunk + 1 < nchunk) { TIDS; const Bufs nb = make_bufs<CH>(kargs(), chunk + 1); h1_rows(nb, kargs()->in[2], CH, bid * 8 + wid, G * 8, lane); }
    }
  }
}

extern "C" void kernel_launch(void* const* d_in, const int* in_sizes, int n_in, void* d_out, int out_size,
                              void* d_ws, size_t ws_size, hipStream_t stream) {
  static int grid_blocks = 0;
  if (!grid_blocks) {
    int dev = 0, cus = 0, per_cu = 0;
    (void)hipGetDevice(&dev);
    (void)hipDeviceGetAttribute(&cus, hipDeviceAttributeMultiprocessorCount, dev);
    (void)hipFuncSetAttribute((const void*)fwd_kernel<32768>, hipFuncAttributeMaxDynamicSharedMemorySize, LDS_BYTES);
    (void)hipFuncSetAttribute((const void*)fwd_kernel<16384>, hipFuncAttributeMaxDynamicSharedMemorySize, LDS_BYTES);
    (void)hipOccupancyMaxActiveBlocksPerMultiprocessor(&per_cu, fwd_kernel<32768>, 512, LDS_BYTES);
    if (per_cu < 1) per_cu = 1;
    grid_blocks = cus * per_cu;
    if (grid_blocks > 256) grid_blocks = 256;
  }
  Args a{};
  for (int i = 0; i < 21; ++i) a.in[i] = (const float*)d_in[i];
  a.out = (float*)d_out; a.ws = (unsigned char*)d_ws;
  const bool big = WS_PERM_END + (size_t)PT_END * 32768 <= ws_size;
  a.CH = big ? 32768 : 16384; a.ph_lo = 0; a.ph_hi = 0; a.pad = 0;
  void* args[] = {&a};
  hipError_t e = hipLaunchCooperativeKernel(big ? (void*)fwd_kernel<32768> : (void*)fwd_kernel<16384>, dim3(grid_blocks), dim3(512), args, LDS_BYTES, stream);
  if (e != hipSuccess) fprintf(stderr, "cooperative launch failed: %s (grid %d)\n", hipGetErrorString(e), grid_blocks);
}
```

```cpp
#include <hip/hip_runtime.h>
#include <hip/hip_cooperative_groups.h>
#include <cstdio>
#include <cstdint>
namespace cg = cooperative_groups;

#define LAS __attribute__((address_space(3)))
typedef unsigned short bf16_t;
typedef short bf16x8 __attribute__((ext_vector_type(8)));
typedef short s16x4 __attribute__((ext_vector_type(4)));
typedef float f32x4 __attribute__((ext_vector_type(4)));
typedef float f32x2 __attribute__((ext_vector_type(2)));
typedef float f32x16 __attribute__((ext_vector_type(16)));
typedef unsigned u32x4 __attribute__((ext_vector_type(4)));
typedef unsigned u32x2 __attribute__((ext_vector_type(2)));

constexpr int DM = 1024, NP = 32768, TT = 98304;
constexpr int N_IN = 5888, N_UP = 5632, DFF = 2816;
constexpr float EPS = 1e-6f;
constexpr int LDS_BYTES = 163840;
#ifndef DUP_ATTN
#define DUP_ATTN 1
#endif
#ifndef DUP_R1
#define DUP_R1 1
#endif
#ifndef DUP_R3
#define DUP_R3 1
#endif
#ifndef DUP_P5
#define DUP_P5 1
#endif
#ifndef DUP_P7
#define DUP_P7 1
#endif
#ifndef DUP_P8
#define DUP_P8 1
#endif
#ifndef DUP_P2G
#define DUP_P2G 1
#endif
#ifndef DUP_P0
#define DUP_P0 1
#endif
#ifndef DUP_P1
#define DUP_P1 1
#endif
#ifndef DUP_P69
#define DUP_P69 1
#endif
#ifndef DUP_SYNC
#define DUP_SYNC 1
#endif
#ifndef PMASK
#define PMASK 0xFFFFF
#endif
#define PM(k) ((PMASK >> (k)) & 1)

constexpr size_t al256(size_t x) { return (x + 255) / 256 * 256; }
constexpr size_t WS_WIN = 0;
constexpr size_t WS_WUQ = WS_WIN + (size_t)N_IN * 1024 * 2;
constexpr size_t WS_WUKV = WS_WUQ + (size_t)2048 * 384 * 2;
constexpr size_t WS_WRO = WS_WUKV + (size_t)2048 * 256 * 2;
constexpr size_t WS_WMO = WS_WRO + (size_t)1024 * 1024 * 2;
constexpr size_t WS_WOUT = WS_WMO + (size_t)1024 * 1024 * 2;
constexpr size_t WS_WUP = WS_WOUT + (size_t)1024 * 1024 * 2;
constexpr size_t WS_WDN = WS_WUP + (size_t)N_UP * 1024 * 2;
constexpr size_t WS_ROPE = WS_WDN + (size_t)1024 * DFF * 2;
constexpr size_t WS_SSQ = WS_ROPE + (size_t)8192 * 64 * 8;
constexpr size_t WS_GP = WS_SSQ + (size_t)30 * TT * 4;
constexpr size_t WS_BAR = al256(WS_GP + 2048);
constexpr size_t WS_PERM_END = al256(WS_BAR + 16384);
constexpr size_t PT_H1O = 0, PT_RG = 2048, PT_RQ = 4096, PT_RK = 5120, PT_RV = 6144, PT_GR = 8192, PT_GA = 10240, PT_CQ = 12288, PT_CKV = 13056,
                 PT_KR = 13568, PT_Q = 13696, PT_K = 16768, PT_V = 19840, PT_URET = 21888, PT_KV = 23936, PT_END = 28032;
constexpr size_t PT_UR = PT_RQ, PT_G = PT_RQ + 11264;
static_assert(PT_G + 5632 <= PT_END, "ffn overlay");

struct Args { const float* in[21]; float* out; unsigned char* ws; int CH; int ph_lo; int ph_hi; int pad; };

__device__ __forceinline__ unsigned cvt_pk(float lo, float hi) { unsigned r; asm volatile("v_cvt_pk_bf16_f32 %0, %1, %2" : "=v"(r) : "v"(lo), "v"(hi)); return r; }
__device__ __forceinline__ float bflo(unsigned w) { return __uint_as_float(w << 16); }
__device__ __forceinline__ float bfhi(unsigned w) { return __uint_as_float(w & 0xffff0000u); }
__device__ __forceinline__ void st8(bf16_t* p, f32x4 a, f32x4 b) { u32x4 w = {cvt_pk(a[0], a[1]), cvt_pk(a[2], a[3]), cvt_pk(b[0], b[1]), cvt_pk(b[2], b[3])}; *(u32x4*)p = w; }
__device__ __forceinline__ void ld8(const bf16_t* p, f32x4& a, f32x4& b) { u32x4 w = *(const u32x4*)p; a = (f32x4){bflo(w.x), bfhi(w.x), bflo(w.y), bfhi(w.y)}; b = (f32x4){bflo(w.z), bfhi(w.z), bflo(w.w), bfhi(w.w)}; }
__device__ __forceinline__ float sigm(float x) { return __builtin_amdgcn_rcpf(1.f + __builtin_amdgcn_exp2f(x * -1.4426950408889634f)); }
typedef __bf16 bf16x2_t __attribute__((ext_vector_type(2)));
__device__ __forceinline__ unsigned cvt_pk_s(float lo, float hi) { f32x2 v = {lo, hi}; bf16x2_t b = __builtin_convertvector(v, bf16x2_t); return __builtin_bit_cast(unsigned, b); }
__device__ __forceinline__ void st8_s(bf16_t* p, f32x4 a, f32x4 b) { u32x4 w = {cvt_pk_s(a[0], a[1]), cvt_pk_s(a[2], a[3]), cvt_pk_s(b[0], b[1]), cvt_pk_s(b[2], b[3])}; *(u32x4*)p = w; }
__device__ __forceinline__ float wave_sum(float v) {
#pragma unroll
  for (int o = 1; o < 64; o <<= 1) v += __shfl_xor(v, o);
  return v;
}
__device__ __forceinline__ float dot4(f32x4 a) { return (a[0] * a[0] + a[1] * a[1]) + (a[2] * a[2] + a[3] * a[3]); }
__device__ __forceinline__ void lds_barrier() { asm volatile("s_waitcnt lgkmcnt(0)" ::: "memory"); __builtin_amdgcn_s_barrier(); asm volatile("" ::: "memory"); }

struct Bufs {
  bf16_t *H1O, *RG, *RQ, *RK, *RV, *GR, *GA, *CQ, *CKV, *KR, *Q, *K, *V, *URET, *KV, *UR, *G;
  const float* rope; float *ssq_cq, *ssq_ckv, *ssq_kr, *ssq_x1; const float *gqp, *gkp;
  const float *xp, *xs; float* out;
  int g0, slm;
};
__device__ __forceinline__ const float* xrow(const Bufs& b, int g) { return g < NP ? b.xp + (size_t)g * DM : b.xs + (size_t)(g - NP) * DM; }

namespace pg8 {
constexpr int BM = 256, BK = 64, HALF = 128, HTB = HALF * BK * 2, STAGE_BYTES = 8 * HTB, NXCD = 8, WGM = 8;
__host__ __device__ __forceinline__ int lds_byte(int r, int c) { const int st = (r >> 4) * 2 + (c >> 5), rr = r & 15, cc = c & 31, ob = rr * 64 + cc * 2; return st * 1024 + (ob ^ (((ob >> 9) & 1) << 5)); }
__host__ __device__ __forceinline__ void stage_rc(int b, int& R, int& C) { const int st = b / 1024, sb = b % 1024, swz = sb ^ (((sb >> 9) & 1) << 5); R = (st >> 1) * 16 + swz / 64; C = (st & 1) * 32 + (swz % 64) / 2; }
__host__ __device__ __forceinline__ int perm32(int rho) { const int n = rho >> 4, i = rho & 15; return 8 * (i >> 2) + 4 * n + (i & 3); }
struct Unit { int pm, pn; };
struct Gemm { const bf16_t* A; const bf16_t* Bt; int M, N, K, lda; };
struct StaticOrder {
  int nM, nN, nwg, G, c;
  __device__ void init(int M, int N, int G_, int c_) { nM = M / BM; nN = N / BM; nwg = nM * nN; G = G_; c = c_; }
  __device__ bool next(int i, Unit& u) const {
    const long L = (long)i * G + c; if (L >= nwg) return false;
    int wgid = (int)L; { const int q = nwg / NXCD, r = nwg % NXCD, xcd = wgid % NXCD, off = wgid / NXCD; wgid = (xcd < r ? xcd * (q + 1) : r * (q + 1) + (xcd - r) * q) + off; }
    const int nig = WGM * nN, gid = wgid / nig, fm = gid * WGM, gsz = (nM - fm) < WGM ? (nM - fm) : WGM;
    u.pm = fm + ((wgid % nig) % gsz); u.pn = (wgid % nig) / gsz; return true;
  }
};

template <class Epi, class Sched>
__device__ __forceinline__ void gemm_phase(LAS unsigned char* lds, const Gemm g, const Sched& S, const Epi& E) {
  constexpr bool ALIGN_EPI = true;
  int tid_ = threadIdx.x; asm volatile("" : "+v"(tid_));
  const int tid = tid_, wid = __builtin_amdgcn_readfirstlane(tid >> 6), lane = tid & 63, wr = wid >> 2, wc = wid & 3, fr = lane & 15, fq = lane >> 4;
  int K = g.K; asm volatile("" : "+s"(K)); const int nt = K / BK, lda = g.lda;
  unsigned voffA[2], voffB[2];
#pragma unroll
  for (int i = 0; i < 2; ++i) { int R, C; stage_rc(tid * 16 + i * 8192, R, C); const int Rb = (R & ~31) + perm32(R & 31);
    voffA[i] = (unsigned)(R * lda + C) * 2u; voffB[i] = (unsigned)(Rb * K + C) * 2u; }
  const size_t kstep = (size_t)(BK * 2);
  const size_t hstepA = (size_t)HALF * lda * 2, tstepA = 2 * hstepA;
  const size_t hstepB = (size_t)HALF * K * 2, tstepB = 2 * hstepB;
  const unsigned ldsw = (unsigned)wid * 1024u;
  const int aoff = lds_byte(wr * 64 + fr, fq * 8), boff = lds_byte(wc * 32 + fr, fq * 8);
#define PG8_SA(b, h) (((b) * 2 + (h)) * HTB)
#define PG8_SB(b, h) ((4 + (b) * 2 + (h)) * HTB)
#define PG8_STAGE(bufoff, gbase, voff) do { _Pragma("unroll") for (int _i = 0; _i < 2; ++_i) \
    __builtin_amdgcn_global_load_lds((const unsigned*)((const char*)(gbase) + (voff)[_i]), (LAS unsigned*)(lds + (bufoff) + ldsw + _i * 8192), 16, 0, 0); } while (0)
#define PG8_LDA(dst, b, h) do { _Pragma("unroll") for (int m = 0; m < 4; ++m) _Pragma("unroll") for (int k = 0; k < 2; ++k) dst[m][k] = *(const LAS bf16x8*)(lds + PG8_SA(b, h) + aoff + m * 2048 + k * 1024); } while (0)
#define PG8_LDB(dst, b, h) do { _Pragma("unroll") for (int n = 0; n < 2; ++n) _Pragma("unroll") for (int k = 0; k < 2; ++k) dst[n][k] = *(const LAS bf16x8*)(lds + PG8_SB(b, h) + boff + n * 2048 + k * 1024); } while (0)
#define PG8_MMA(ai, bj, At, Bt) do { __builtin_amdgcn_s_setprio(1); _Pragma("unroll") for (int m = 0; m < 4; ++m) _Pragma("unroll") for (int n = 0; n < 2; ++n) _Pragma("unroll") for (int k = 0; k < 2; ++k) \
    acc[ai][bj][m][n] = __builtin_amdgcn_mfma_f32_16x16x32_bf16(Bt[n][k], At[m][k], acc[ai][bj][m][n], 0, 0, 0); __builtin_amdgcn_s_setprio(0); } while (0)
#define PG8_WAIT_V(n) asm volatile("s_waitcnt vmcnt(" #n ")" ::: "memory")
#define PG8_WAIT_L(n) asm volatile("s_waitcnt lgkmcnt(" #n ")" ::: "memory")
#define PG8_BAR __builtin_amdgcn_s_barrier()
#define PG8_SCHED __builtin_amdgcn_sched_barrier(0)
  Unit cur, nxt; int ui = 0;
  if (!S.next(0, cur)) return;
  f32x4 acc[2][2][4][2];
#pragma unroll
  for (int a = 0; a < 2; ++a)
#pragma unroll
    for (int b = 0; b < 2; ++b)
#pragma unroll
      for (int m = 0; m < 4; ++m)
#pragma unroll
        for (int n = 0; n < 2; ++n) acc[a][b][m][n] = (f32x4){0.f, 0.f, 0.f, 0.f};
  bf16x8 At[4][2], B0[2][2], B1[2][2];
  const char* cA = (const char*)g.A + (size_t)cur.pm * tstepA; const char* cB = (const char*)g.Bt + (size_t)cur.pn * tstepB;
  PG8_STAGE(PG8_SB(0, 0), cB, voffB); PG8_STAGE(PG8_SB(0, 1), cB + hstepB, voffB); PG8_STAGE(PG8_SA(0, 0), cA, voffA); PG8_STAGE(PG8_SA(0, 1), cA + hstepA, voffA);
  if (wr == 1) PG8_BAR;
  PG8_WAIT_V(2); PG8_BAR;
  PG8_STAGE(PG8_SB(1, 0), cB + kstep, voffB); PG8_STAGE(PG8_SA(1, 0), cA + kstep, voffA); PG8_STAGE(PG8_SB(1, 1), cB + hstepB + kstep, voffB);
  PG8_WAIT_V(6); PG8_BAR;
  for (;;) {
    const bool has_next = S.next(ui + 1, nxt);
    const char* nA = has_next ? (const char*)g.A + (size_t)nxt.pm * tstepA : cA; const char* nB = has_next ? (const char*)g.Bt + (size_t)nxt.pn * tstepB : cB;
    for (int t = 0; t < nt; t += 2) {
      const bool last = (t == nt - 2);
      const char* a1 = cA + (size_t)(t + 1) * kstep;
      const char* a2 = last ? nA : cA + (size_t)(t + 2) * kstep; const char* b2 = last ? nB : cB + (size_t)(t + 2) * kstep;
      const char* a3 = a2 + kstep; const char* b3 = b2 + kstep;
      PG8_LDB(B0, 0, 0); PG8_LDB(B1, 0, 1); PG8_SCHED; PG8_LDA(At, 0, 0); PG8_STAGE(PG8_SA(1, 1), a1 + hstepA, voffA);
      PG8_WAIT_V(8); PG8_WAIT_L(0); PG8_BAR; PG8_MMA(0, 0, At, B0); PG8_MMA(0, 1, At, B1); PG8_BAR; PG8_SCHED;
      PG8_LDA(At, 0, 1); PG8_STAGE(PG8_SB(0, 0), b2, voffB); PG8_STAGE(PG8_SB(0, 1), b2 + hstepB, voffB); PG8_STAGE(PG8_SA(0, 0), a2, voffA);
      PG8_WAIT_V(8); PG8_WAIT_L(0); PG8_BAR; PG8_MMA(1, 0, At, B0); PG8_MMA(1, 1, At, B1); PG8_BAR; PG8_SCHED;
      PG8_LDB(B0, 1, 0); PG8_LDB(B1, 1, 1); PG8_SCHED; PG8_LDA(At, 1, 0); PG8_STAGE(PG8_SA(0, 1), a2 + hstepA, voffA);
      PG8_WAIT_V(8); PG8_WAIT_L(0); PG8_BAR; PG8_MMA(0, 0, At, B0); PG8_MMA(0, 1, At, B1); PG8_BAR; PG8_SCHED;
      PG8_LDA(At, 1, 1); PG8_STAGE(PG8_SB(1, 0), b3, voffB); PG8_STAGE(PG8_SB(1, 1), b3 + hstepB, voffB); PG8_STAGE(PG8_SA(1, 0), a3, voffA);
      PG8_WAIT_V(8); PG8_WAIT_L(0); PG8_BAR; PG8_MMA(1, 0, At, B0); PG8_MMA(1, 1, At, B1); PG8_BAR; PG8_SCHED;
    }
    if constexpr (ALIGN_EPI) { if (wr == 0) PG8_BAR; }
    { int fr2 = fr, fq2 = fq; asm volatile("" : "+v"(fr2), "+v"(fq2)); E(acc, cur, wr, wc, fr2, fq2, lds + STAGE_BYTES); }
    if (!has_next) break;
#pragma unroll
    for (int a = 0; a < 2; ++a)
#pragma unroll
      for (int b = 0; b < 2; ++b)
#pragma unroll
        for (int m = 0; m < 4; ++m)
#pragma unroll
          for (int n = 0; n < 2; ++n) acc[a][b][m][n] = (f32x4){0.f, 0.f, 0.f, 0.f};
    cur = nxt; cA = nA; cB = nB; ++ui;
    if constexpr (ALIGN_EPI) { if (wr == 1) PG8_BAR; }
  }
  PG8_WAIT_V(0);
  if constexpr (!ALIGN_EPI) { if (wr == 0) PG8_BAR; }
  PG8_BAR;
#undef PG8_SA
#undef PG8_SB
#undef PG8_STAGE
#undef PG8_LDA
#undef PG8_LDB
#undef PG8_MMA
#undef PG8_WAIT_V
#undef PG8_WAIT_L
#undef PG8_BAR
#undef PG8_SCHED
}
}
using pg8::Unit;

#define SBAR0() __builtin_amdgcn_sched_barrier(0)
#define EPI_ARGS const f32x4 (&acc)[2][2][4][2], const Unit& u, int wr, int wc, int fr, int fq, LAS unsigned char* scr
#define FOR_AI_M _Pragma("unroll") for (int ai = 0; ai < 2; ++ai) if ((__builtin_amdgcn_sched_barrier(0), true)) _Pragma("unroll") for (int m = 0; m < 4; ++m)

__device__ __forceinline__ void rope4(f32x4& v0, f32x4& v1, f32x4 t0, f32x4 t1) {
  f32x4 o0 = {v0[0] * t0[0] - v0[1] * t0[1], v0[0] * t0[1] + v0[1] * t0[0], v0[2] * t0[2] - v0[3] * t0[3], v0[2] * t0[3] + v0[3] * t0[2]};
  f32x4 o1 = {v1[0] * t1[0] - v1[1] * t1[1], v1[0] * t1[1] + v1[1] * t1[0], v1[2] * t1[2] - v1[3] * t1[3], v1[2] * t1[3] + v1[3] * t1[2]};
  v0 = o0; v1 = o1;
}

struct EpiIn {
  Bufs b; bool at;
  __device__ __forceinline__ void rope_store(const f32x4 (&acc)[2][2][4][2], bf16_t* dst, float sc, int hsel, int rbase, int wc, int fq) const {
    const int c0 = wc * 32 + fq * 8, i0 = wc * 16 + fq * 4;
    FOR_AI_M { const int row = rbase + ai * 128 + m * 16, pos = (b.g0 + row) & b.slm;
      const f32x4* tp = (const f32x4*)(b.rope + ((size_t)pos * 64 + i0) * 2); const f32x4 t0 = tp[0], t1 = tp[1];
#pragma unroll
      for (int bj = 0; bj < 2; ++bj) { f32x4 v0 = acc[ai][bj][m][0], v1 = acc[ai][bj][m][1]; rope4(v0, v1, t0, t1);
        st8(dst + (size_t)row * 512 + (hsel * 2 + bj) * 128 + c0, v0 * sc, v1 * sc); } }
  }
  template <int ACT> __device__ __forceinline__ void plain_store(const f32x4 (&acc)[2][2][4][2], bf16_t* dst, int cbase, int rbase) const {
    FOR_AI_M { const int row = rbase + ai * 128 + m * 16;
#pragma unroll
      for (int bj = 0; bj < 2; ++bj) { f32x4 v0 = acc[ai][bj][m][0], v1 = acc[ai][bj][m][1];
        if (ACT == 1) {
#pragma unroll
          for (int e = 0; e < 4; ++e) { v0[e] = v0[e] * sigm(v0[e]); v1[e] = v1[e] * sigm(v1[e]); } }
        if (ACT == 2) {
#pragma unroll
          for (int e = 0; e < 4; ++e) { v0[e] = sigm(v0[e]); v1[e] = sigm(v1[e]); } }
        if (ACT == 0) st8(dst + (size_t)row * 1024 + cbase + bj * 128, v0, v1); else st8_s(dst + (size_t)row * 1024 + cbase + bj * 128, v0, v1); } }
  }
  __device__ __forceinline__ void ssq_store(const f32x4 (&acc)[2][2][4][2], bf16_t* dst, int ld, float* sq, int ns, int slot, int rbase, int c0, int fq) const {
    FOR_AI_M { const int row = rbase + ai * 128 + m * 16; float s = 0.f;
#pragma unroll
      for (int bj = 0; bj < 2; ++bj) { const f32x4 v0 = acc[ai][bj][m][0], v1 = acc[ai][bj][m][1]; s += dot4(v0) + dot4(v1); st8(dst + (size_t)row * ld + bj * 128 + c0, v0, v1); }
      s += __shfl_xor(s, 16); s += __shfl_xor(s, 32); if (fq == 0 && at) sq[(size_t)(b.g0 + row) * ns + slot] = s; }
  }
  __device__ __forceinline__ void operator()(EPI_ARGS) const {
    const int pn = u.pn, rbase = u.pm * 256 + wr * 64 + fr, c0 = wc * 32 + fq * 8;
    if (pn < 2) rope_store(acc, b.RQ, 1.f, pn, rbase, wc, fq);
    else if (pn < 4) rope_store(acc, b.RK, 0.08838834764831845f, pn - 2, rbase, wc, fq);
    else if (pn < 8) plain_store<0>(acc, b.RV, (pn - 4) * 256 + c0, rbase);
    else if (pn < 12) plain_store<1>(acc, b.RG, (pn - 8) * 256 + c0, rbase);
    else if (pn < 16) plain_store<2>(acc, b.GR, (pn - 12) * 256 + c0, rbase);
    else if (pn < 20) plain_store<2>(acc, b.GA, (pn - 16) * 256 + c0, rbase);
    else if (pn == 20) ssq_store(acc, b.CQ, 384, b.ssq_cq, 8, wc, rbase, c0, fq);
    else if (pn == 22) ssq_store(acc, b.CKV, 256, b.ssq_ckv, 4, wc, rbase, c0, fq);
    else {
      FOR_AI_M { const int row = rbase + ai * 128 + m * 16, pos = (b.g0 + row) & b.slm;
        { const f32x4 v0 = acc[ai][0][m][0], v1 = acc[ai][0][m][1]; float s = dot4(v0) + dot4(v1); st8(b.CQ + (size_t)row * 384 + 256 + c0, v0, v1);
          s += __shfl_xor(s, 16); s += __shfl_xor(s, 32); if (fq == 0 && at) b.ssq_cq[(size_t)(b.g0 + row) * 8 + 4 + wc] = s; }
        if (wc < 2) { f32x4 v0 = acc[ai][1][m][0], v1 = acc[ai][1][m][1]; const int j0 = wc * 16 + fq * 4;
          const f32x2* tp = (const f32x2*)(b.rope + ((size_t)pos * 64 + 2 * j0) * 2); const f32x2 a0 = tp[0], a1 = tp[2], a2 = tp[4], a3 = tp[6];
          rope4(v0, v1, (f32x4){a0[0], a0[1], a1[0], a1[1]}, (f32x4){a2[0], a2[1], a3[0], a3[1]});
          float s = dot4(v0) + dot4(v1); st8(b.KR + (size_t)row * 64 + c0, v0, v1);
          s += __shfl_xor(s, 16); s += __shfl_xor(s, 32); if (fq == 0 && at) b.ssq_kr[(size_t)(b.g0 + row) * 2 + wc] = s; } }
    }
  }
};

__device__ __forceinline__ void xwave_rowsum(float (&part)[8], int wr, int wc, int fr, int fq, LAS unsigned char* scr) {
  LAS float* red = (LAS float*)scr;
  if (fq == 0) {
#pragma unroll
    for (int i = 0; i < 8; ++i) red[((wr * 4 + wc) * 8 + i) * 16 + fr] = part[i];
  }
  lds_barrier();
#pragma unroll
  for (int i = 0; i < 8; ++i) part[i] = (red[((wr * 4 + 0) * 8 + i) * 16 + fr] + red[((wr * 4 + 1) * 8 + i) * 16 + fr]) + (red[((wr * 4 + 2) * 8 + i) * 16 + fr] + red[((wr * 4 + 3) * 8 + i) * 16 + fr]);
}

struct EpiQ {
  Bufs b;
  __device__ __forceinline__ void operator()(EPI_ARGS) const {
    const int head = u.pn, rbase = u.pm * 256 + wr * 64 + fr, c0 = wc * 32 + fq * 8;
    float part[8];
    FOR_AI_M { float s = 0.f;
#pragma unroll
      for (int bj = 0; bj < 2; ++bj) s += dot4(acc[ai][bj][m][0]) + dot4(acc[ai][bj][m][1]);
      s += __shfl_xor(s, 16); s += __shfl_xor(s, 32); part[ai * 4 + m] = s; }
    xwave_rowsum(part, wr, wc, fr, fq, scr);
    const float* gqp = b.gqp; asm volatile("" : "+s"(gqp));
    const f32x4 g0 = *(const f32x4*)(gqp + c0), g1 = *(const f32x4*)(gqp + c0 + 4), h0 = *(const f32x4*)(gqp + 128 + c0), h1 = *(const f32x4*)(gqp + 128 + c0 + 4);
    FOR_AI_M { const int i = ai * 4 + m, row = rbase + ai * 128 + m * 16, pos = (b.g0 + row) & b.slm;
      const f32x4* sp = (const f32x4*)(b.ssq_cq + (size_t)(b.g0 + row) * 8); const f32x4 s0 = sp[0], s1 = sp[1];
      const float r1 = rsqrtf((((s0[0] + s0[1]) + (s0[2] + s0[3])) + ((s1[0] + s1[1]) + (s1[2] + s1[3]))) * (1.f / 384.f) + EPS);
      const float f = r1 * rsqrtf(r1 * r1 * part[i] * (1.f / 192.f) + EPS) * 0.10411754002f;
      bf16_t* qp = b.Q + (size_t)row * 1536 + head * 192;
      st8(qp + c0, acc[ai][0][m][0] * g0 * f, acc[ai][0][m][1] * g1 * f);
      if (wc < 2) { f32x4 v0 = acc[ai][1][m][0] * h0 * f, v1 = acc[ai][1][m][1] * h1 * f; const int j0 = wc * 16 + fq * 4;
        const f32x2* tp = (const f32x2*)(b.rope + ((size_t)pos * 64 + 2 * j0) * 2); const f32x2 a0 = tp[0], a1 = tp[2], a2 = tp[4], a3 = tp[6];
        rope4(v0, v1, (f32x4){a0[0], a0[1], a1[0], a1[1]}, (f32x4){a2[0], a2[1], a3[0], a3[1]});
        st8(qp + 128 + c0, v0, v1); } }
  }
};

struct EpiKV {
  Bufs b;
  __device__ __forceinline__ void operator()(EPI_ARGS) const {
    const int head = u.pn, rbase = u.pm * 256 + wr * 64 + fr, c0 = wc * 32 + fq * 8;
    float part[8], rs[8];
    FOR_AI_M { const int row = rbase + ai * 128 + m * 16; { const f32x4 s0 = *(const f32x4*)(b.ssq_ckv + (size_t)(b.g0 + row) * 4); rs[ai * 4 + m] = rsqrtf(((s0[0] + s0[1]) + (s0[2] + s0[3])) * (1.f / 256.f) + EPS); }
      float s = dot4(acc[ai][0][m][0]) + dot4(acc[ai][0][m][1]);
      s += __shfl_xor(s, 16); s += __shfl_xor(s, 32); part[ai * 4 + m] = s; }
    xwave_rowsum(part, wr, wc, fr, fq, scr);
    const float* gkp = b.gkp; asm volatile("" : "+s"(gkp));
    const f32x4 g0 = *(const f32x4*)(gkp + c0), g1 = *(const f32x4*)(gkp + c0 + 4);
    const int kc0 = (wc * 4 + fq) * 4; const f32x4 gr = *(const f32x4*)(gkp + 128 + kc0);
    FOR_AI_M { const int i = ai * 4 + m, row = rbase + ai * 128 + m * 16, pos = (b.g0 + row) & b.slm;
      const float r1 = rs[i], rsk = rsqrtf((r1 * r1 * part[i] + (b.ssq_kr[(size_t)(b.g0 + row) * 2] + b.ssq_kr[(size_t)(b.g0 + row) * 2 + 1])) * (1.f / 192.f) + EPS), f = r1 * rsk;
      bf16_t* kp = b.K + (size_t)row * 1536 + head * 192;
      st8(kp + c0, acc[ai][0][m][0] * g0 * f, acc[ai][0][m][1] * g1 * f);
      st8(b.V + (size_t)row * 1024 + head * 128 + c0, acc[ai][1][m][0] * r1, acc[ai][1][m][1] * r1);
      const u32x2 w = *(const u32x2*)(b.KR + (size_t)row * 64 + kc0);
      const float x0 = bflo(w.x) * gr[0], y0 = bfhi(w.x) * gr[1], x1 = bflo(w.y) * gr[2], y1 = bfhi(w.y) * gr[3];
      const f32x2* tp = (const f32x2*)(b.rope + ((size_t)pos * 64 + kc0) * 2); const f32x2 a0 = tp[0], a1 = tp[2];
      u32x2 o; o.x = cvt_pk((x0 * a0[0] - y0 * a0[1]) * rsk, (x0 * a0[1] + y0 * a0[0]) * rsk); o.y = cvt_pk((x1 * a1[0] - y1 * a1[1]) * rsk, (x1 * a1[1] + y1 * a1[0]) * rsk);
      *(u32x2*)(kp + 128 + kc0) = o; }
  }
};

template <int mode> struct EpiGate {
  Bufs b;
  __device__ __forceinline__ void operator()(EPI_ARGS) const {
    const int rbase = u.pm * 256 + wr * 64 + fr, c0 = u.pn * 256 + wc * 32 + fq * 8; const bf16_t* gate = mode ? b.GA : b.GR; bf16_t* mg = b.RV;
#pragma unroll
    for (int ai = 0; ai < 2; ++ai) {
      SBAR0();
      u32x4 gt[4][2], pv[4][2];
#pragma unroll
      for (int m = 0; m < 4; ++m)
#pragma unroll
        for (int bj = 0; bj < 2; ++bj) { const size_t idx = (size_t)(rbase + ai * 128 + m * 16) * 1024 + c0 + bj * 128; gt[m][bj] = *(const u32x4*)(gate + idx); if (mode) pv[m][bj] = *(const u32x4*)(mg + idx); }
#pragma unroll
      for (int m = 0; m < 4; ++m)
#pragma unroll
        for (int bj = 0; bj < 2; ++bj) { const size_t idx = (size_t)(rbase + ai * 128 + m * 16) * 1024 + c0 + bj * 128; const u32x4 g = gt[m][bj];
          f32x4 v0 = acc[ai][bj][m][0] * (f32x4){bflo(g.x), bfhi(g.x), bflo(g.y), bfhi(g.y)}, v1 = acc[ai][bj][m][1] * (f32x4){bflo(g.z), bfhi(g.z), bflo(g.w), bfhi(g.w)};
          if (mode) { const u32x4 p = pv[m][bj]; v0 += (f32x4){bflo(p.x), bfhi(p.x), bflo(p.y), bfhi(p.y)}; v1 += (f32x4){bflo(p.z), bfhi(p.z), bflo(p.w), bfhi(p.w)}; }
          st8(mg + idx, v0, v1); }
    }
  }
};

struct EpiOut {
  Bufs b; bool at;
  __device__ __forceinline__ void operator()(EPI_ARGS) const {
    const int rbase = u.pm * 256 + wr * 64 + fr, c0 = u.pn * 256 + wc * 32 + fq * 8;
#pragma unroll
    for (int ai = 0; ai < 2; ++ai) {
      SBAR0();
      f32x4 xv[4][2][2];
#pragma unroll
      for (int m = 0; m < 4; ++m) { const float* xr = xrow(b, b.g0 + rbase + ai * 128 + m * 16);
#pragma unroll
        for (int bj = 0; bj < 2; ++bj) { xv[m][bj][0] = *(const f32x4*)(xr + c0 + bj * 128); xv[m][bj][1] = *(const f32x4*)(xr + c0 + bj * 128 + 4); } }
#pragma unroll
      for (int m = 0; m < 4; ++m) { const int row = rbase + ai * 128 + m * 16, g = b.g0 + row; float s = 0.f;
#pragma unroll
        for (int bj = 0; bj < 2; ++bj) { const int c = c0 + bj * 128; const f32x4 v0 = acc[ai][bj][m][0] + xv[m][bj][0], v1 = acc[ai][bj][m][1] + xv[m][bj][1];
          st8(b.RG + (size_t)row * 1024 + c, v0, v1); s += dot4(v0) + dot4(v1); }
        s += __shfl_xor(s, 16); s += __shfl_xor(s, 32); if (fq == 0 && at) b.ssq_x1[(size_t)g * 16 + u.pn * 4 + wc] = s; }
    }
  }
};

struct EpiUp {
  Bufs b;
  __device__ __forceinline__ void operator()(EPI_ARGS) const {
    const int rbase = u.pm * 256 + wr * 64 + fr, c0 = u.pn * 256 + wc * 32 + fq * 8;
    FOR_AI_M { const int row = rbase + ai * 128 + m * 16; const f32x4* sp = (const f32x4*)(b.ssq_x1 + (size_t)(b.g0 + row) * 16); const f32x4 q0 = sp[0], q1 = sp[1], q2 = sp[2], q3 = sp[3];
      const float r2 = rsqrtf(((((q0[0] + q0[1]) + (q0[2] + q0[3])) + ((q1[0] + q1[1]) + (q1[2] + q1[3]))) + (((q2[0] + q2[1]) + (q2[2] + q2[3])) + ((q3[0] + q3[1]) + (q3[2] + q3[3])))) * (1.f / 1024.f) + EPS);
#pragma unroll
      for (int bj = 0; bj < 2; ++bj) st8(b.UR + (size_t)row * N_UP + c0 + bj * 128, acc[ai][bj][m][0] * r2, acc[ai][bj][m][1] * r2); }
  }
};

struct EpiDown {
  Bufs b; bool at;
  __device__ __forceinline__ void operator()(EPI_ARGS) const {
    const int rbase = u.pm * 256 + wr * 64 + fr, c0 = u.pn * 256 + wc * 32 + fq * 8;
#pragma unroll
    for (int ai = 0; ai < 2; ++ai) {
      SBAR0();
      u32x4 xv[4][2];
#pragma unroll
      for (int m = 0; m < 4; ++m)
#pragma unroll
        for (int bj = 0; bj < 2; ++bj) xv[m][bj] = *(const u32x4*)(b.RG + (size_t)(rbase + ai * 128 + m * 16) * 1024 + c0 + bj * 128);
      if (at) {
#pragma unroll
        for (int m = 0; m < 4; ++m) { float* orow = b.out + (size_t)(b.g0 + rbase + ai * 128 + m * 16) * DM;
#pragma unroll
          for (int bj = 0; bj < 2; ++bj) { const int c = c0 + bj * 128; const u32x4 p = xv[m][bj];
            *(f32x4*)(orow + c) = (f32x4){bflo(p.x), bfhi(p.x), bflo(p.y), bfhi(p.y)} + acc[ai][bj][m][0]; *(f32x4*)(orow + c + 4) = (f32x4){bflo(p.z), bfhi(p.z), bflo(p.w), bfhi(p.w)} + acc[ai][bj][m][1]; } }
      }
    }
  }
};

#define SBAR() __builtin_amdgcn_sched_barrier(0)
__device__ __forceinline__ int crow(int r, int hi) { return (r & 3) + 8 * (r >> 2) + 4 * hi; }
__device__ __forceinline__ int v_st(int k, int c) { const int kk = (k & ~0xC) | ((k & 4) << 1) | ((k & 8) >> 1); return ((kk >> 3) * 4 + (c >> 5)) * 512 + ((kk & 7) * 32 + (c & 31)) * 2; }
__device__ __forceinline__ int v_rd_base(int lane) { return ((lane & 3) << 3) | (((lane >> 2) & 3) << 6) | (((lane >> 4) & 1) << 5) | (((lane >> 5) & 1) << 8); }
constexpr int v_rd_off(int d0, int ks, int half) { return d0 * 512 + ks * 4096 + half * 2048; }
template <int OFF> __device__ __forceinline__ s16x4 tr_read(int vb) {
  s16x4 r; asm volatile("ds_read_b64_tr_b16 %0, %1 offset:%2" : "=&v"(r) : "v"(vb), "i"(OFF) : "memory"); return r;
}
#define PKLH(L, H) (bf16x8){L[0], L[1], L[2], L[3], H[0], H[1], H[2], H[3]}
template <int D0> __device__ __forceinline__ void pv_one(f32x16& od, int vb, bf16x8 pa0, bf16x8 pa1, bf16x8 pa2, bf16x8 pa3) {
  const s16x4 l0 = tr_read<v_rd_off(D0, 0, 0)>(vb), h0 = tr_read<v_rd_off(D0, 0, 1)>(vb), l1 = tr_read<v_rd_off(D0, 1, 0)>(vb), h1 = tr_read<v_rd_off(D0, 1, 1)>(vb);
  const s16x4 l2 = tr_read<v_rd_off(D0, 2, 0)>(vb), h2 = tr_read<v_rd_off(D0, 2, 1)>(vb), l3 = tr_read<v_rd_off(D0, 3, 0)>(vb), h3 = tr_read<v_rd_off(D0, 3, 1)>(vb);
  asm volatile("s_waitcnt lgkmcnt(0)" ::: "memory"); SBAR();
  od = __builtin_amdgcn_mfma_f32_32x32x16_bf16(pa0, PKLH(l0, h0), od, 0, 0, 0);
  od = __builtin_amdgcn_mfma_f32_32x32x16_bf16(pa1, PKLH(l1, h1), od, 0, 0, 0);
  od = __builtin_amdgcn_mfma_f32_32x32x16_bf16(pa2, PKLH(l2, h2), od, 0, 0, 0);
  od = __builtin_amdgcn_mfma_f32_32x32x16_bf16(pa3, PKLH(l3, h3), od, 0, 0, 0);
}
template <int D0> __device__ __forceinline__ void pv_issue(s16x4 (&t)[8], int vb) {
  t[0] = tr_read<v_rd_off(D0, 0, 0)>(vb); t[1] = tr_read<v_rd_off(D0, 0, 1)>(vb); t[2] = tr_read<v_rd_off(D0, 1, 0)>(vb); t[3] = tr_read<v_rd_off(D0, 1, 1)>(vb);
  t[4] = tr_read<v_rd_off(D0, 2, 0)>(vb); t[5] = tr_read<v_rd_off(D0, 2, 1)>(vb); t[6] = tr_read<v_rd_off(D0, 3, 0)>(vb); t[7] = tr_read<v_rd_off(D0, 3, 1)>(vb);
}
__device__ __forceinline__ void pv_mma(f32x16& od, const s16x4 (&t)[8], bf16x8 pa0, bf16x8 pa1, bf16x8 pa2, bf16x8 pa3) {
  od = __builtin_amdgcn_mfma_f32_32x32x16_bf16(pa0, PKLH(t[0], t[1]), od, 0, 0, 0);
  od = __builtin_amdgcn_mfma_f32_32x32x16_bf16(pa1, PKLH(t[2], t[3]), od, 0, 0, 0);
  od = __builtin_amdgcn_mfma_f32_32x32x16_bf16(pa2, PKLH(t[4], t[5]), od, 0, 0, 0);
  od = __builtin_amdgcn_mfma_f32_32x32x16_bf16(pa3, PKLH(t[6], t[7]), od, 0, 0, 0);
}
__device__ __forceinline__ void pv_d0(f32x16* o, int vb, bf16x8 pa0, bf16x8 pa1, bf16x8 pa2, bf16x8 pa3) {
  s16x4 ta[8], tb[8];
  pv_issue<0>(ta, vb);
  pv_issue<1>(tb, vb); asm volatile("s_waitcnt lgkmcnt(8)" ::: "memory"); SBAR(); pv_mma(o[0], ta, pa0, pa1, pa2, pa3);
  pv_issue<2>(ta, vb); asm volatile("s_waitcnt lgkmcnt(8)" ::: "memory"); SBAR(); pv_mma(o[1], tb, pa0, pa1, pa2, pa3);
  pv_issue<3>(tb, vb); asm volatile("s_waitcnt lgkmcnt(8)" ::: "memory"); SBAR(); pv_mma(o[2], ta, pa0, pa1, pa2, pa3);
  asm volatile("s_waitcnt lgkmcnt(0)" ::: "memory"); SBAR(); pv_mma(o[3], tb, pa0, pa1, pa2, pa3);
}
#define PK4(P, BASE, OUT) do { unsigned a0 = cvt_pk(P[BASE + 0], P[BASE + 1]), a1 = cvt_pk(P[BASE + 2], P[BASE + 3]);   \
    unsigned b0 = cvt_pk(P[BASE + 4], P[BASE + 5]), b1 = cvt_pk(P[BASE + 6], P[BASE + 7]);                              \
    auto r0 = __builtin_amdgcn_permlane32_swap(a0, b0, false, false); auto r1 = __builtin_amdgcn_permlane32_swap(a1, b1, false, false); \
    u32x4 w = {r0[0], r1[0], r0[1], r1[1]}; OUT = *reinterpret_cast<bf16x8*>(&w); } while (0)

namespace att {
constexpr int DQK = 192, DV = 128, NW = 8, QBLK = 32, KVBLK = 64, NQD = DQK / 16;
constexpr int LDQ = 1536, LDK = 1536, LDV = 1024, LDO = 1024;
constexpr float SCALE = 0.07216878364870323f, THR = 8.f;
constexpr int SHM_V = KVBLK * DV * 2, SHM_K = KVBLK * DQK * 2;
#define KSWZ3(row, colB) ((row) * 384 + ((colB) ^ ((((row) >> 1) & 7) << 4)))
__device__ __forceinline__ void partialSM(f32x16& p0, f32x16& p1, float& m_reg, float& alpha, bool first) {
  constexpr float THR2 = THR * 1.4426950408889634f;
  float pmax = p0[0];
#pragma unroll
  for (int r = 1; r < 16; ++r) pmax = fmaxf(pmax, p0[r]);
#pragma unroll
  for (int r = 0; r < 16; ++r) pmax = fmaxf(pmax, p1[r]);
  { auto rr = __builtin_amdgcn_permlane32_swap(__float_as_uint(pmax), __float_as_uint(pmax), false, false);
    pmax = fmaxf(__uint_as_float(rr[0]), __uint_as_float(rr[1])); }
  if (__builtin_expect(!first && __all(pmax <= THR2), 1)) { alpha = 1.f; }
  else { const float d = first ? pmax : fmaxf(pmax, 0.f); alpha = __builtin_amdgcn_exp2f(-d); m_reg += d;
#pragma unroll
    for (int r = 0; r < 16; ++r) { p0[r] -= d; p1[r] -= d; } }
#pragma unroll
  for (int r = 0; r < 16; ++r) p0[r] = __builtin_amdgcn_exp2f(p0[r]);
}
__device__ __forceinline__ void finishSM(f32x16& p0, f32x16& p1, float alpha, float& l_reg, bf16x8& pa0, bf16x8& pa1, bf16x8& pa2, bf16x8& pa3) {
#pragma unroll
  for (int r = 0; r < 16; ++r) p1[r] = __builtin_amdgcn_exp2f(p1[r]);
  float ps = 0;
#pragma unroll
  for (int r = 0; r < 16; ++r) ps += p0[r];
#pragma unroll
  for (int r = 0; r < 16; ++r) ps += p1[r];
  { auto rr = __builtin_amdgcn_permlane32_swap(__float_as_uint(ps), __float_as_uint(ps), false, false);
    ps = __uint_as_float(rr[0]) + __uint_as_float(rr[1]); }
  l_reg = l_reg * alpha + ps;
  PK4(p0, 0, pa0); PK4(p0, 8, pa1); PK4(p1, 0, pa2); PK4(p1, 8, pa3);
}
__device__ __forceinline__ void qkt(f32x16& p0, f32x16& p1, const char* Ks, const bf16x8* qr, const char* qrl, int qsw, int r32, int hi, float init) {
#pragma unroll
  for (int r = 0; r < 16; ++r) { p0[r] = init; p1[r] = init; }
#pragma unroll
  for (int d0 = 0; d0 < 8; ++d0) { int cb = (d0 * 16 + hi * 8) * 2;
    bf16x8 b0 = *reinterpret_cast<const bf16x8*>(Ks + KSWZ3(r32, cb));
    bf16x8 b1 = *reinterpret_cast<const bf16x8*>(Ks + KSWZ3(32 + r32, cb));
    p0 = __builtin_amdgcn_mfma_f32_32x32x16_bf16(b0, qr[d0], p0, 0, 0, 0);
    p1 = __builtin_amdgcn_mfma_f32_32x32x16_bf16(b1, qr[d0], p1, 0, 0, 0); }
#pragma unroll
  for (int d0 = 0; d0 < 4; ++d0) { int cb = ((8 + d0) * 16 + hi * 8) * 2;
    bf16x8 q = *reinterpret_cast<const bf16x8*>(qrl + (((d0 * 2 + hi) ^ qsw) << 4));
    bf16x8 b0 = *reinterpret_cast<const bf16x8*>(Ks + KSWZ3(r32, cb));
    bf16x8 b1 = *reinterpret_cast<const bf16x8*>(Ks + KSWZ3(32 + r32, cb));
    p0 = __builtin_amdgcn_mfma_f32_32x32x16_bf16(b0, q, p0, 0, 0, 0);
    p1 = __builtin_amdgcn_mfma_f32_32x32x16_bf16(b1, q, p1, 0, 0, 0); }
}
__device__ __forceinline__ void attn_unit(const bf16_t* __restrict__ Qb, const bf16_t* __restrict__ Kh, const bf16_t* __restrict__ Vh, bf16_t* __restrict__ Ob, int seq, char* lds, LAS unsigned char* ldsl) {
  int tid_ = threadIdx.x; asm volatile("" : "+v"(tid_));
  const int tid = tid_, wid = __builtin_amdgcn_readfirstlane(tid >> 6), lane = tid & 63, r32 = lane & 31, hi = lane >> 5;
  constexpr int OFF_K = 3 * SHM_V, OFF_WS = 3 * SHM_V + 3 * SHM_K;
  char* V_lds = lds; char* K_lds = lds + OFF_K;
  float* ws = (float*)(lds + OFF_WS) + wid * 64; float* li_l = ws; float* al_l = ws + 32;
  float m_reg = 0.f, l_reg = 0; f32x16 o[4] = {}; bf16x8 qr[8];
  const bf16_t* Qw = Qb + (long)(wid * QBLK + r32) * LDQ + hi * 8;
#pragma unroll
  for (int d0 = 0; d0 < 8; ++d0) qr[d0] = *reinterpret_cast<const bf16x8*>(Qw + d0 * 16);
  char* qrl = lds + OFF_WS + 2048 + wid * 4096 + r32 * 128;
  const int qsw = (r32 >> 1) & 7;
#pragma unroll
  for (int d0 = 0; d0 < 4; ++d0) *(bf16x8*)(qrl + (((d0 * 2 + hi) ^ qsw) << 4)) = *reinterpret_cast<const bf16x8*>(Qw + 128 + d0 * 16);
  int kof[3], vof[2];
#pragma unroll
  for (int i = 0; i < 3; ++i) { const int L = (wid * 3 + i) * 1024 + lane * 16, row = L / 384, x = L - row * 384, cb = x ^ (((row >> 1) & 7) << 4); kof[i] = row * LDK + (cb >> 1); }
#pragma unroll
  for (int i = 0; i < 2; ++i) { const int L = (wid * 2 + i) * 1024 + lane * 16, sub = L >> 9, w = L & 511, kk = (sub >> 2) * 8 + (w >> 6), c = (sub & 3) * 32 + ((w & 63) >> 1);
    const int k = (kk & ~0xC) | ((kk & 4) << 1) | ((kk & 8) >> 1); vof[i] = k * LDV + c; }
  const int vb0 = (int)(uintptr_t)V_lds + v_rd_base(lane);
#define KVDMA(t, slot) do { const bf16_t* kb_ = Kh + (long)(t) * (KVBLK * LDK); const bf16_t* vb_ = Vh + (long)(t) * (KVBLK * LDV); \
    _Pragma("unroll") for (int i_ = 0; i_ < 3; ++i_) __builtin_amdgcn_global_load_lds((const unsigned*)(kb_ + kof[i_]), (LAS unsigned*)(ldsl + OFF_K + (slot) * SHM_K + (wid * 3 + i_) * 1024), 16, 0, 0); \
    _Pragma("unroll") for (int i_ = 0; i_ < 2; ++i_) __builtin_amdgcn_global_load_lds((const unsigned*)(vb_ + vof[i_]), (LAS unsigned*)(ldsl + (slot) * SHM_V + (wid * 2 + i_) * 1024), 16, 0, 0); } while (0)
#define TILE_SYNC() do { asm volatile("s_waitcnt vmcnt(0)" ::: "memory"); __syncthreads(); } while (0)
#define RESC(a) do { if (__any((a) < 1.f)) { if (hi == 0) al_l[r32] = (a); asm volatile("s_waitcnt lgkmcnt(0)" ::: "memory"); \
    _Pragma("unroll") for (int d = 0; d < 4; ++d) _Pragma("unroll") for (int r = 0; r < 16; ++r) o[d][r] *= al_l[crow(r, hi)]; } } while (0)
  f32x16 pA0, pA1, pB0, pB1; float alA, alB; bf16x8 pa0, pa1, pa2, pa3; const int NT = seq / KVBLK;
  KVDMA(0, 0); KVDMA(1, 1); TILE_SYNC();
  qkt(pA0, pA1, K_lds, qr, qrl, qsw, r32, hi, 0.f); partialSM(pA0, pA1, m_reg, alA, true);
  int sK = 1, sV = 0, sN = 2;
#define NEXT3(x) ((x) == 2 ? 0 : (x) + 1)
  for (int j = 1; j + 1 < NT; j += 2) {
    KVDMA(j + 1, sN);
    SBAR(); qkt(pB0, pB1, K_lds + sK * SHM_K, qr, qrl, qsw, r32, hi, -m_reg);
    finishSM(pA0, pA1, alA, l_reg, pa0, pa1, pa2, pa3); SBAR();
    pv_d0(o, vb0 + sV * SHM_V, pa0, pa1, pa2, pa3); partialSM(pB0, pB1, m_reg, alB, false);
    RESC(alB); TILE_SYNC();
    sV = sK; sK = sN; sN = NEXT3(sN);
    if (j + 2 < NT) KVDMA(j + 2, sN);
    SBAR(); qkt(pA0, pA1, K_lds + sK * SHM_K, qr, qrl, qsw, r32, hi, -m_reg);
    finishSM(pB0, pB1, alB, l_reg, pa0, pa1, pa2, pa3); SBAR();
    pv_d0(o, vb0 + sV * SHM_V, pa0, pa1, pa2, pa3); partialSM(pA0, pA1, m_reg, alA, false);
    RESC(alA); TILE_SYNC();
    sV = sK; sK = sN; sN = NEXT3(sN);
  }
  SBAR(); qkt(pB0, pB1, K_lds + sK * SHM_K, qr, qrl, qsw, r32, hi, -m_reg);
  finishSM(pA0, pA1, alA, l_reg, pa0, pa1, pa2, pa3); SBAR();
  pv_d0(o, vb0 + sV * SHM_V, pa0, pa1, pa2, pa3); partialSM(pB0, pB1, m_reg, alB, false);
  RESC(alB);
  finishSM(pB0, pB1, alB, l_reg, pa0, pa1, pa2, pa3); SBAR();
  pv_d0(o, vb0 + sK * SHM_V, pa0, pa1, pa2, pa3);
  if (hi == 0) li_l[r32] = l_reg; asm volatile("s_waitcnt lgkmcnt(0)" ::: "memory");
  float rli[16];
#pragma unroll
  for (int r = 0; r < 16; ++r) rli[r] = __builtin_amdgcn_rcpf(li_l[crow(r, hi)]);
  bf16_t* Ow = Ob + (long)(wid * QBLK) * LDO;
#pragma unroll
  for (int r = 0; r < 16; ++r) { int orow = crow(r, hi);
#pragma unroll
    for (int d0 = 0; d0 < 4; ++d0) Ow[(long)orow * LDO + d0 * 32 + r32] = (bf16_t)(cvt_pk(o[d0][r] * rli[r], 0.f) & 0xffffu); }
  __syncthreads();
#undef KVDMA
#undef TILE_SYNC
#undef RESC
#undef NEXT3
}
}

#define KSWZ(row, colB) ((row) * 256 + ((colB) ^ ((((row) & 7) << 4) | ((((row) >> 3) & 1) << 7))))
__device__ __forceinline__ bf16x8 scale8(bf16x8 x, float s) {
  u32x4 w = *reinterpret_cast<u32x4*>(&x);
  u32x4 o = {cvt_pk(bflo(w.x) * s, bfhi(w.x) * s), cvt_pk(bflo(w.y) * s, bfhi(w.y) * s), cvt_pk(bflo(w.z) * s, bfhi(w.z) * s), cvt_pk(bflo(w.w) * s, bfhi(w.w) * s)};
  return *reinterpret_cast<bf16x8*>(&o);
}
__device__ __forceinline__ void stage_v_chunk(const bf16_t* Vg, char* lds, int tid) {
#pragma unroll
  for (int i = 0; i < 8; ++i) { const int p = tid + 512 * i, row = p >> 5, col = (p & 31) * 8;
    const bf16x8 v = *reinterpret_cast<const bf16x8*>(Vg + (size_t)row * 1024 + col);
    *(bf16x8*)(lds + ((row >> 6) * 2 + (col >> 7)) * 16384 + v_st(row & 63, col & 127)) = v; }
}
template <int OFF> __device__ __forceinline__ bf16x8 tr_frag(int base) { const s16x4 l = tr_read<OFF>(base), h = tr_read<OFF + 2048>(base); asm volatile("s_waitcnt lgkmcnt(0)" ::: "memory"); return PKLH(l, h); }

__device__ __forceinline__ void ret_kv_item(const Bufs& b, int item, float lgf2, float lgb2, char* lds) {
  int tid_ = threadIdx.x; asm volatile("" : "+v"(tid_));
  const int tid = tid_, wid = tid >> 6, lane = tid & 63, r32 = lane & 31, hi = lane >> 5;
  const int ci = item >> 2, h = item & 3; const size_t tok0 = (size_t)ci * 128;
  const bf16_t* Kg = b.RK + tok0 * 512 + h * 128; const bf16_t* Vg = b.RV + tok0 * 1024 + h * 256;
  stage_v_chunk(Vg, lds, tid);
#pragma unroll
  for (int i = 0; i < 4; ++i) { const int p = tid + 512 * i, row = p >> 4, col = (p & 15) * 8;
    const bf16x8 k = *reinterpret_cast<const bf16x8*>(Kg + (size_t)row * 512 + col);
    const float sf = __builtin_amdgcn_exp2f(lgf2 * (float)(127 - row)), sb = __builtin_amdgcn_exp2f(lgb2 * (float)row);
    const int off = (row >> 6) * 16384 + v_st(row & 63, col);
    *(bf16x8*)(lds + 65536 + off) = scale8(k, sf); *(bf16x8*)(lds + 98304 + off) = scale8(k, sb); }
  __syncthreads();
  const int rb = v_rd_base(lane), lb = (int)(uintptr_t)lds;
  const int vbase = lb + (wid >> 2) * 16384 + rb + (wid & 3) * 512;
#define R1_STEP(T, KS, KOFF) do { const bf16x8 a = tr_frag<v_rd_off(0, KS, 0)>(vbase + (T) * 32768); \
    { const int kf = lb + (KOFF) + (T) * 16384 + rb; \
      const bf16x8 f0 = tr_frag<v_rd_off(0, KS, 0)>(kf), f1 = tr_frag<v_rd_off(1, KS, 0)>(kf), f2 = tr_frag<v_rd_off(2, KS, 0)>(kf), f3 = tr_frag<v_rd_off(3, KS, 0)>(kf); \
      aF[0] = __builtin_amdgcn_mfma_f32_32x32x16_bf16(a, f0, aF[0], 0, 0, 0); aF[1] = __builtin_amdgcn_mfma_f32_32x32x16_bf16(a, f1, aF[1], 0, 0, 0); \
      aF[2] = __builtin_amdgcn_mfma_f32_32x32x16_bf16(a, f2, aF[2], 0, 0, 0); aF[3] = __builtin_amdgcn_mfma_f32_32x32x16_bf16(a, f3, aF[3], 0, 0, 0); } SBAR(); } while (0)
#pragma unroll
  for (int dir = 0; dir < 2; ++dir) {
    f32x16 aF[4] = {};
    if (dir == 0) { R1_STEP(0, 0, 65536); R1_STEP(0, 1, 65536); R1_STEP(0, 2, 65536); R1_STEP(0, 3, 65536); R1_STEP(1, 0, 65536); R1_STEP(1, 1, 65536); R1_STEP(1, 2, 65536); R1_STEP(1, 3, 65536); }
    else { R1_STEP(0, 0, 98304); R1_STEP(0, 1, 98304); R1_STEP(0, 2, 98304); R1_STEP(0, 3, 98304); R1_STEP(1, 0, 98304); R1_STEP(1, 1, 98304); R1_STEP(1, 2, 98304); R1_STEP(1, 3, 98304); }
    bf16_t* od = b.KV + (size_t)item * 65536 + dir * 32768;
#pragma unroll
    for (int n0 = 0; n0 < 4; ++n0)
#pragma unroll
      for (int r = 0; r < 16; ++r) od[(32 * wid + crow(r, hi)) * 128 + 32 * n0 + r32] = (bf16_t)(cvt_pk_s(aF[n0][r], 0.f) & 0xffffu);
    SBAR();
  }
#undef R1_STEP
  __syncthreads();
}

__device__ __forceinline__ float lg2_of(const float* dec, int h);
__device__ __forceinline__ void ret_scan(const Bufs& b, int nseq, int NC, const float* dec_f, const float* dec_b, int gtid, int gthreads) {
  const int nvec = nseq * 32768;
  for (int v = gtid; v < nvec; v += gthreads) {
    const int e8 = v & 4095, dir = (v >> 12) & 1, h = (v >> 13) & 3, s = v >> 15;
    const float decay = __builtin_amdgcn_exp2f(lg2_of(dir ? dec_b : dec_f, h) * 128.f);
    float st[8];
#pragma unroll
    for (int e = 0; e < 8; ++e) st[e] = 0.f;
    for (int step = 0; step < NC; step += 4) {
      u32x4 kv[4]; bf16_t* ptr[4];
#pragma unroll
      for (int q = 0; q < 4; ++q) { const int c = dir ? NC - 1 - (step + q) : step + q; ptr[q] = b.KV + ((size_t)(((s * NC + c) * 4 + h) * 2 + dir)) * 32768 + e8 * 8; kv[q] = *(const u32x4*)ptr[q]; }
#pragma unroll
      for (int q = 0; q < 4; ++q) {
        u32x4 o = {cvt_pk(st[0], st[1]), cvt_pk(st[2], st[3]), cvt_pk(st[4], st[5]), cvt_pk(st[6], st[7])}; *(u32x4*)ptr[q] = o;
        st[0] = st[0] * decay + bflo(kv[q].x); st[1] = st[1] * decay + bfhi(kv[q].x); st[2] = st[2] * decay + bflo(kv[q].y); st[3] = st[3] * decay + bfhi(kv[q].y);
        st[4] = st[4] * decay + bflo(kv[q].z); st[5] = st[5] * decay + bfhi(kv[q].z); st[6] = st[6] * decay + bflo(kv[q].w); st[7] = st[7] * decay + bfhi(kv[q].w); }
    }
  }
}

__device__ __forceinline__ void qkt128(f32x16& p0, f32x16& p1, const char* Ks, const bf16x8* qr, int r32, int hi) {
  p0 = f32x16{}; p1 = f32x16{};
#pragma unroll
  for (int d0 = 0; d0 < 8; ++d0) { int cb = (d0 * 16 + hi * 8) * 2;
    bf16x8 b0 = *reinterpret_cast<const bf16x8*>(Ks + KSWZ(r32, cb));
    bf16x8 b1 = *reinterpret_cast<const bf16x8*>(Ks + KSWZ(32 + r32, cb));
    p0 = __builtin_amdgcn_mfma_f32_32x32x16_bf16(b0, qr[d0], p0, 0, 0, 0);
    p1 = __builtin_amdgcn_mfma_f32_32x32x16_bf16(b1, qr[d0], p1, 0, 0, 0); }
}
__device__ __forceinline__ void ret_out_item(const Bufs& b, int item, float lgf2, float lgb2, const float* gn_g, char* lds) {
  int tid_ = threadIdx.x; asm volatile("" : "+v"(tid_));
  const int tid = tid_, wid = tid >> 6, lane = tid & 63, r32 = lane & 31, hi = lane >> 5, wr = wid & 3, wc = wid >> 2;
  const int ci = item >> 2, h = item & 3; const size_t tok0 = (size_t)ci * 128;
  const bf16_t* Qg = b.RQ + tok0 * 512 + h * 128; const bf16_t* Kg = b.RK + tok0 * 512 + h * 128; const bf16_t* Vg = b.RV + tok0 * 1024 + h * 256;
  const bf16_t* Sf = b.KV + (size_t)item * 65536; const bf16_t* Sb = Sf + 32768;
  char* K_lds = lds; char* V_lds = lds + 32768;
#pragma unroll
  for (int i = 0; i < 4; ++i) { const int p = tid + 512 * i, row = p >> 4, col = (p & 15) * 8;
    *(bf16x8*)(K_lds + KSWZ(row, col * 2)) = *reinterpret_cast<const bf16x8*>(Kg + (size_t)row * 512 + col); }
  stage_v_chunk(Vg, V_lds, tid);
  bf16x8 qr[8];
  { const bf16_t* Qw = Qg + (size_t)(wr * 32 + r32) * 512 + hi * 8;
#pragma unroll
    for (int d0 = 0; d0 < 8; ++d0) qr[d0] = *reinterpret_cast<const bf16x8*>(Qw + d0 * 16); }
  __syncthreads();
  f32x16 o[4] = {};
  const int irow = wr * 32 + r32;
#pragma unroll
  for (int t = 0; t < 2; ++t) {
    f32x16 p0, p1; qkt128(p0, p1, K_lds + t * 16384, qr, r32, hi);
#pragma unroll
    for (int r = 0; r < 16; ++r) { const int j0 = 64 * t + crow(r, hi), d0_ = irow - j0, d1_ = d0_ - 32;
      p0[r] *= __builtin_amdgcn_exp2f(d0_ >= 0 ? lgf2 * (float)d0_ : lgb2 * (float)(-d0_));
      p1[r] *= __builtin_amdgcn_exp2f(d1_ >= 0 ? lgf2 * (float)d1_ : lgb2 * (float)(-d1_)); }
    bf16x8 pa0, pa1, pa2, pa3; PK4(p0, 0, pa0); PK4(p0, 8, pa1); PK4(p1, 0, pa2); PK4(p1, 8, pa3);
    pv_d0(o, (int)(uintptr_t)V_lds + (t * 2 + wc) * 16384 + v_rd_base(lane), pa0, pa1, pa2, pa3);
    SBAR();
  }
  __syncthreads();
#pragma unroll
  for (int i = 0; i < 8; ++i) { const int p = tid + 512 * i, row = p >> 4, col = (p & 15) * 8;
    *(bf16x8*)(lds + KSWZ(row, col * 2)) = *reinterpret_cast<const bf16x8*>(Sf + (size_t)row * 128 + col);
    *(bf16x8*)(lds + 65536 + KSWZ(row, col * 2)) = *reinterpret_cast<const bf16x8*>(Sb + (size_t)row * 128 + col); }
  const float qdf = __builtin_amdgcn_exp2f(lgf2 * (float)(irow + 1)), qdb = __builtin_amdgcn_exp2f(lgb2 * (float)(128 - irow));
  __syncthreads();
#pragma unroll
  for (int s = 0; s < 8; ++s) { const bf16x8 af = scale8(qr[s], qdf), ab = scale8(qr[s], qdb); const int cb = (s * 16 + hi * 8) * 2;
#pragma unroll
    for (int d = 0; d < 4; ++d) { const int srow = 128 * wc + 32 * d + r32;
      const bf16x8 bf = *reinterpret_cast<const bf16x8*>(lds + KSWZ(srow, cb)), bb = *reinterpret_cast<const bf16x8*>(lds + 65536 + KSWZ(srow, cb));
      o[d] = __builtin_amdgcn_mfma_f32_32x32x16_bf16(af, bf, o[d], 0, 0, 0);
      o[d] = __builtin_amdgcn_mfma_f32_32x32x16_bf16(ab, bb, o[d], 0, 0, 0); }
    SBAR(); }
  const int nrow = tid >> 2, nq = tid & 3; const size_t gofs = (tok0 + nrow) * 1024 + h * 256 + nq * 8; u32x4 rgv[8];
#pragma unroll
  for (int k = 0; k < 8; ++k) rgv[k] = *(const u32x4*)(b.RG + gofs + 32 * k);
  __syncthreads();
  float* ol = (float*)lds;
#pragma unroll
  for (int d = 0; d < 4; ++d)
#pragma unroll
    for (int r = 0; r < 16; ++r) ol[(wr * 32 + crow(r, hi)) * 260 + wc * 128 + d * 32 + r32] = o[d][r];
  __syncthreads();
  { const int row = nrow, q = nq; const float* rp = ol + row * 260 + q * 8;
    f32x4 x[16]; float s = 0.f;
#pragma unroll
    for (int k = 0; k < 8; ++k) { x[2 * k] = *(const f32x4*)(rp + 32 * k); x[2 * k + 1] = *(const f32x4*)(rp + 32 * k + 4); s += (x[2 * k][0] + x[2 * k][1]) + (x[2 * k][2] + x[2 * k][3]) + (x[2 * k + 1][0] + x[2 * k + 1][1]) + (x[2 * k + 1][2] + x[2 * k + 1][3]); }
    s += __shfl_xor(s, 1); s += __shfl_xor(s, 2); const float mu = s * (1.f / 256.f); float v = 0.f;
#pragma unroll
    for (int k = 0; k < 16; ++k) { x[k] = x[k] - mu; v += dot4(x[k]); }
    v += __shfl_xor(v, 1); v += __shfl_xor(v, 2); const float rstd = rsqrtf(v * (1.f / 256.f) + EPS);
    const float* gp = gn_g + h * 256 + q * 8;
#pragma unroll
    for (int k = 0; k < 8; ++k) { const u32x4 rw = rgv[k]; const f32x4 ga = {bflo(rw.x), bfhi(rw.x), bflo(rw.y), bfhi(rw.y)}, gb = {bflo(rw.z), bfhi(rw.z), bflo(rw.w), bfhi(rw.w)}; const f32x4 w0 = *(const f32x4*)(gp + 32 * k), w1 = *(const f32x4*)(gp + 32 * k + 4);
      st8(b.URET + gofs + 32 * k, x[2 * k] * rstd * w0 * ga, x[2 * k + 1] * rstd * w1 * gb); } }
  __syncthreads();
}

__device__ __forceinline__ int src_col(int mat, int n) {
  if (mat == 0) {
    if (n < 1024) { const int base = n & ~127, hc = n & 127; return base + ((hc & 1) ? (hc >> 1) + 64 : (hc >> 1)); }
    if (n < 3072) return n;
    if (n < 4096) return 3776 + (n - 3072);
    if (n < 5120) return 4800 + (n - 4096);
    if (n < 5504) return 3072 + (n - 5120);
    if (n < 5568) { const int kc = n - 5504; return 3712 + ((kc & 1) ? (kc >> 1) + 32 : (kc >> 1)); }
    if (n < 5632) return -1;
    return 3456 + (n - 5632);
  }
  if (mat == 1) { const int head = n >> 8, hc = n & 255; if (hc < 128) return head * 192 + hc; if (hc < 192) { const int kc = hc - 128; return head * 192 + 128 + ((kc & 1) ? (kc >> 1) + 32 : (kc >> 1)); } return -1; }
  return n;
}
__device__ __forceinline__ void prep_tile(const float* W, int K, int Nsrc, const float* gain, bf16_t* Bt, int mat, int n0, int k0, float* scr, int tid) {
  const int tx = tid & 63, ty = tid >> 6; const int src = src_col(mat, n0 + tx);
#pragma unroll
  for (int kk = ty; kk < 64; kk += 8) { float v = 0.f; if (src >= 0) { v = W[(size_t)(k0 + kk) * Nsrc + src]; if (gain) v *= gain[k0 + kk]; } scr[kk * 65 + tx] = v; }
  __syncthreads();
  { const int n = tid >> 3, kq = (tid & 7) * 8; const float* s = scr + kq * 65 + n;
    u32x4 o = {cvt_pk(s[0], s[65]), cvt_pk(s[130], s[195]), cvt_pk(s[260], s[325]), cvt_pk(s[390], s[455])};
    *(u32x4*)(Bt + (size_t)(n0 + n) * K + k0 + kq) = o; }
  __syncthreads();
}
__device__ __forceinline__ void h1_rows(const Bufs& b, const float* gmix, int CH, int gw, int ngw_, int lane_) {
  int lane = lane_; asm volatile("" : "+v"(lane)); int ngw = ngw_; asm volatile("" : "+s"(ngw));
  for (int r = gw * 4; r < CH; r += ngw * 4) {
    f32x4 v[4][4]; float s[4];
#pragma unroll
    for (int q = 0; q < 4; ++q) { const f32x4* xq = (const f32x4*)xrow(b, b.g0 + r + q) + lane;
#pragma unroll
      for (int j = 0; j < 4; ++j) v[q][j] = xq[64 * j]; }
#pragma unroll
    for (int q = 0; q < 4; ++q) { s[q] = 0.f;
#pragma unroll
      for (int j = 0; j < 4; ++j) s[q] += dot4(v[q][j]); }
#pragma unroll
    for (int o = 1; o < 64; o <<= 1) {
#pragma unroll
      for (int q = 0; q < 4; ++q) s[q] += __shfl_xor(s[q], o); }
#pragma unroll
    for (int q = 0; q < 4; ++q) { const float rs = rsqrtf(s[q] * (1.f / 1024.f) + EPS); u32x2* oq = (u32x2*)(b.H1O + (size_t)(r + q) * 1024) + lane;
#pragma unroll
      for (int j = 0; j < 4; ++j) { const f32x4 g = ((const f32x4*)gmix)[lane + 64 * j]; const f32x4 y = v[q][j] * rs * g; u32x2 w = {cvt_pk(y[0], y[1]), cvt_pk(y[2], y[3])}; oq[64 * j] = w; } } }
}
__device__ __forceinline__ void conv_gate(const Bufs& b, const float* cw, const float* cbias, int CH, int bid, int nb, int tid) {
  if (tid >= 352) return;
  const int c = tid * 8;
  float w[2][3][8], bs[2][8];
#pragma unroll
  for (int hf = 0; hf < 2; ++hf) {
#pragma unroll
    for (int k = 0; k < 3; ++k) { const f32x4 a = *(const f32x4*)(cw + (size_t)k * N_UP + hf * DFF + c), d = *(const f32x4*)(cw + (size_t)k * N_UP + hf * DFF + c + 4);
#pragma unroll
      for (int e = 0; e < 4; ++e) { w[hf][k][e] = a[e]; w[hf][k][4 + e] = d[e]; } }
    const f32x4 a = *(const f32x4*)(cbias + hf * DFF + c), d = *(const f32x4*)(cbias + hf * DFF + c + 4);
#pragma unroll
    for (int e = 0; e < 4; ++e) { bs[hf][e] = a[e]; bs[hf][4 + e] = d[e]; } }
  for (int strip = bid; strip < CH / 8; strip += nb) {
    const int r0 = strip * 8; const int pos0 = (b.g0 + r0) & b.slm;
    u32x4 raw[2][10];
    const bool hp = pos0 > 0, hn = (pos0 + 8) <= b.slm;
#pragma unroll
    for (int hf = 0; hf < 2; ++hf) {
      const bf16_t* base = b.UR + (size_t)r0 * N_UP + hf * DFF + c;
      raw[hf][0] = hp ? *(const u32x4*)(base - N_UP) : (u32x4){0u, 0u, 0u, 0u};
#pragma unroll
      for (int i = 0; i < 8; ++i) raw[hf][1 + i] = *(const u32x4*)(base + (size_t)i * N_UP);
      raw[hf][9] = hn ? *(const u32x4*)(base + (size_t)8 * N_UP) : (u32x4){0u, 0u, 0u, 0u};
    }
#pragma unroll
    for (int i = 0; i < 8; ++i) {
      float ua[8], ub[8];
#pragma unroll
      for (int e = 0; e < 8; ++e) { ua[e] = bs[0][e]; ub[e] = bs[1][e]; }
#pragma unroll
      for (int k = 0; k < 3; ++k) { const u32x4 xa = raw[0][i + k], xb = raw[1][i + k];
        const float fa[8] = {bflo(xa.x), bfhi(xa.x), bflo(xa.y), bfhi(xa.y), bflo(xa.z), bfhi(xa.z), bflo(xa.w), bfhi(xa.w)};
        const float fb[8] = {bflo(xb.x), bfhi(xb.x), bflo(xb.y), bfhi(xb.y), bflo(xb.z), bfhi(xb.z), bflo(xb.w), bfhi(xb.w)};
#pragma unroll
        for (int e = 0; e < 8; ++e) { ua[e] += fa[e] * w[0][k][e]; ub[e] += fb[e] * w[1][k][e]; } }
      f32x4 y0, y1;
#pragma unroll
      for (int e = 0; e < 4; ++e) { y0[e] = ua[e] * sigm(ua[e]) * ub[e]; y1[e] = ua[4 + e] * sigm(ua[4 + e]) * ub[4 + e]; }
      st8(b.G + (size_t)(r0 + i) * DFF + c, y0, y1);
    }
  }
}


#define XB_TMO      128
#define XB_XCNT(j)  (256  + 64 * (j))
#define XB_XSUB(j)  (1280 + 64 * (j))
#define XB_XGEN(j)  (2304 + 64 * (j))
#define XB_TOP      3328
#define XB_TOPGEN   3392
#define XCD_BAR_WORDS 3456
#define XB_SPIN_CAP (1u << 18)
__device__ __forceinline__ unsigned xb_ld(unsigned* p)              { return __hip_atomic_load(p, __ATOMIC_RELAXED, __HIP_MEMORY_SCOPE_AGENT); }
__device__ __forceinline__ unsigned xb_add(unsigned* p, unsigned v) { return __hip_atomic_fetch_add(p, v, __ATOMIC_RELAXED, __HIP_MEMORY_SCOPE_AGENT); }
__device__ __forceinline__ unsigned xb_xcc_id() { return (unsigned)__builtin_amdgcn_s_getreg((3 << 11) | 20) & 0xFu; }
#define XB_SPIN(cond, bar) do { unsigned _sp = 0; while (cond) { __builtin_amdgcn_s_sleep(1); \
    if ((++_sp & 255u) == 0u) { if (xb_ld(&(bar)[XB_TMO])) break; if (_sp > XB_SPIN_CAP) { atomicAdd(&(bar)[XB_TMO], 1u); break; } } } } while (0)
struct XcdBarrier { unsigned* bar; unsigned x; volatile LAS unsigned* st; };
__device__ __forceinline__ XcdBarrier xcd_barrier_post(unsigned* bar, volatile LAS unsigned* st) {
  XcdBarrier b; b.bar = bar; b.x = xb_xcc_id(); b.st = st;
  if (threadIdx.x == 0) (void)xb_add(&bar[XB_XCNT(b.x)], 1u);
  return b;
}
__device__ __forceinline__ void xcd_barrier_complete(unsigned* bar, unsigned x, unsigned& nloc, unsigned& nx) {
  const unsigned G = gridDim.x * gridDim.y * gridDim.z;
  unsigned sum, cnt, mine, sp = 0u;
  for (;;) {
    sum = 0u; cnt = 0u; mine = 0u;
#pragma unroll
    for (unsigned j = 0; j < 16; ++j) { const unsigned c = xb_ld(&bar[XB_XCNT(j)]); sum += c; cnt += (c > 0u) ? 1u : 0u; mine = (j == x) ? c : mine; }
    if (sum == G) break;
    __builtin_amdgcn_s_sleep(1);
    if ((++sp & 255u) == 0u) { if (xb_ld(&bar[XB_TMO])) break; if (sp > XB_SPIN_CAP) { atomicAdd(&bar[XB_TMO], 1u); break; } }
  }
  nloc = mine > 0u ? mine : 1u; nx = cnt > 0u ? cnt : 1u;
}
__device__ __forceinline__ void xcd_barrier(const XcdBarrier& b) {
  asm volatile("s_waitcnt vmcnt(0)" ::: "memory");
  __syncthreads();
  if (threadIdx.x == 0) {
    unsigned* bar = b.bar;
    __builtin_amdgcn_s_waitcnt(0);
    unsigned nloc = b.st[0], nx = b.st[1];
    if (nloc == 0u) { xcd_barrier_complete(bar, b.x, nloc, nx); b.st[0] = nloc; b.st[1] = nx; }
    const unsigned old = xb_add(&bar[XB_XSUB(b.x)], 1u);
    const unsigned gen = old / nloc;
    if (old + 1u == (gen + 1u) * nloc) {
      __builtin_amdgcn_fence(__ATOMIC_RELEASE, "agent");
      asm volatile("s_waitcnt vmcnt(0)" ::: "memory");
      const unsigned og = xb_add(&bar[XB_TOP], 1u);
      const unsigned tg = og / nx;
      if (og + 1u == (tg + 1u) * nx) xb_add(&bar[XB_TOPGEN], 1u);
      else XB_SPIN(xb_ld(&bar[XB_TOPGEN]) == tg, bar);
      __builtin_amdgcn_fence(__ATOMIC_ACQUIRE, "agent");
      xb_add(&bar[XB_XGEN(b.x)], 1u);
      asm volatile("s_waitcnt vmcnt(0)" ::: "memory");
    } else {
      XB_SPIN(xb_ld(&bar[XB_XGEN(b.x)]) == gen, bar);
      __builtin_amdgcn_fence(__ATOMIC_ACQUIRE, "agent");
      asm volatile("s_waitcnt vmcnt(0)" ::: "memory");
    }
  }
  __syncthreads();
}

typedef const __attribute__((address_space(4))) Args* KArgsP;
__device__ __forceinline__ KArgsP kargs() { KArgsP p = (KArgsP)__builtin_amdgcn_kernarg_segment_ptr(); asm volatile("" : "+s"(p)); return p; }
template <int CHT> __device__ __forceinline__ Bufs make_bufs(KArgsP ap, int chunk) {
  Bufs b; unsigned char* ws = ap->ws; asm volatile("" : "+s"(ws)); unsigned char* cb = ws + WS_PERM_END; constexpr size_t CH = (size_t)CHT;
  b.H1O = (bf16_t*)(cb + PT_H1O * CH); b.RG = (bf16_t*)(cb + PT_RG * CH); b.RQ = (bf16_t*)(cb + PT_RQ * CH); b.RK = (bf16_t*)(cb + PT_RK * CH); b.RV = (bf16_t*)(cb + PT_RV * CH);
  b.GR = (bf16_t*)(cb + PT_GR * CH); b.GA = (bf16_t*)(cb + PT_GA * CH); b.CQ = (bf16_t*)(cb + PT_CQ * CH); b.CKV = (bf16_t*)(cb + PT_CKV * CH); b.KR = (bf16_t*)(cb + PT_KR * CH);
  b.Q = (bf16_t*)(cb + PT_Q * CH); b.K = (bf16_t*)(cb + PT_K * CH); b.V = (bf16_t*)(cb + PT_V * CH); b.URET = (bf16_t*)(cb + PT_URET * CH); b.KV = (bf16_t*)(cb + PT_KV * CH);
  b.UR = (bf16_t*)(cb + PT_UR * CH); b.G = (bf16_t*)(cb + PT_G * CH);
  b.rope = (const float*)(ws + WS_ROPE); float* sq = (float*)(ws + WS_SSQ); b.ssq_cq = sq; b.ssq_ckv = sq + 8 * (size_t)TT; b.ssq_kr = sq + 12 * (size_t)TT; b.ssq_x1 = sq + 14 * (size_t)TT;
  b.gqp = (const float*)(ws + WS_GP); b.gkp = b.gqp + 256;
  b.xp = ap->in[0]; b.xs = ap->in[1]; b.out = ap->out; b.g0 = chunk * CHT; b.slm = (b.g0 < NP) ? 4095 : 8191;
  return b;
}

__device__ __forceinline__ float lg2_of(const float* dec, int h) { return -log1pf(__expf(-dec[h])) * 1.4426950408889634f; }
template <int CH>
__global__ void __launch_bounds__(512, 2) fwd_kernel(Args a) {
  extern __shared__ __attribute__((aligned(16))) unsigned char lds_raw[];
  LAS unsigned char* lds = (LAS unsigned char*)lds_raw;
  char* ldsg = (char*)lds_raw;
  const int bid = blockIdx.x, G = gridDim.x;
  constexpr int nchunk = TT / CH;
  volatile LAS unsigned* bst = (volatile LAS unsigned*)(lds + LDS_BYTES - 16);
  if (threadIdx.x == 0) { bst[0] = 0u; bst[1] = 0u; }
  __syncthreads();
  XcdBarrier xbar; xbar.bar = nullptr; xbar.x = 0; xbar.st = bst;
#define PHASE_BEGIN(do_it) { for (int rs_ = 0; rs_ < DUP_SYNC; ++rs_) { XcdBarrier xb_ = xbar; xb_.bar = (unsigned*)(kargs()->ws + WS_BAR); xcd_barrier(xb_); } do_it = true; }
#define TIDS int tid = threadIdx.x; asm volatile("" : "+v"(tid)); const int lane = tid & 63, wid = tid >> 6; (void)lane; (void)wid
#define WSL unsigned char* ws = kargs()->ws; asm volatile("" : "+s"(ws))
#define WT(off) ((bf16_t*)(ws + (off)))
  bool run;
  run = true;
  if (run && PM(0)) for (int rep_ = 0; rep_ < DUP_P0; ++rep_) {
    TIDS; WSL; const int gtid = bid * 512 + tid, gthreads = G * 512;
    {
      const int T0 = 92 * 16, T1 = T0 + 32 * 6, T2 = T1 + 32 * 4, T3 = T2 + 256, T4 = T3 + 256, T5 = T4 + 256, T6 = T5 + 88 * 16, T7 = T6 + 16 * 44;
      for (int t = bid; t < T7; t += G) {
        if (t < T0) { prep_tile(kargs()->in[3], 1024, 5824, nullptr, WT(WS_WIN), 0, (t / 16) * 64, (t % 16) * 64, (float*)ldsg, tid); }
        else if (t < T1) { const int q = t - T0; prep_tile(kargs()->in[9], 384, 1536, kargs()->in[8], WT(WS_WUQ), 1, (q / 6) * 64, (q % 6) * 64, (float*)ldsg, tid); }
        else if (t < T2) { const int q = t - T1; prep_tile(kargs()->in[11], 256, 2048, kargs()->in[10], WT(WS_WUKV), 2, (q / 4) * 64, (q % 4) * 64, (float*)ldsg, tid); }
        else if (t < T3) { const int q = t - T2; prep_tile(kargs()->in[7], 1024, 1024, nullptr, WT(WS_WRO), 2, (q / 16) * 64, (q % 16) * 64, (float*)ldsg, tid); }
        else if (t < T4) { const int q = t - T3; prep_tile(kargs()->in[14], 1024, 1024, nullptr, WT(WS_WMO), 2, (q / 16) * 64, (q % 16) * 64, (float*)ldsg, tid); }
        else if (t < T5) { const int q = t - T4; prep_tile(kargs()->in[15], 1024, 1024, nullptr, WT(WS_WOUT), 2, (q / 16) * 64, (q % 16) * 64, (float*)ldsg, tid); }
        else if (t < T6) { const int q = t - T5; prep_tile(kargs()->in[17], 1024, N_UP, kargs()->in[16], WT(WS_WUP), 2, (q / 16) * 64, (q % 16) * 64, (float*)ldsg, tid); }
        else { const int q = t - T6; prep_tile(kargs()->in[20], DFF, 1024, nullptr, WT(WS_WDN), 2, (q / 44) * 64, (q % 44) * 64, (float*)ldsg, tid); }
      }
    }
    { float* rope = (float*)(ws + WS_ROPE);
      for (int i = gtid; i < 8192 * 64; i += gthreads) { const int pos = i >> 6, fi = i & 63;
        const double inv = exp2(-(double)fi * (13.287712379549449 / 64.0)); double rev = (double)pos * inv * 0.15915494309189535; rev -= floor(rev);
        const float rf = (float)rev; rope[2 * i] = __builtin_amdgcn_cosf(rf); rope[2 * i + 1] = __builtin_amdgcn_sinf(rf); } }
    if (bid == 0) { unsigned* bw = (unsigned*)(ws + WS_BAR); for (int i = tid; i < 4096; i += 512) bw[i] = 0u; }
    if (bid == 0 && tid < 256) { float* gp = (float*)(ws + WS_GP); const int c = tid; const float *g_qn = kargs()->in[12], *g_kn = kargs()->in[13];
      float q, k; if (c < 128) { q = g_qn[c]; k = g_kn[c]; } else if (c < 192) { const int kc = c - 128, d = (kc & 1) ? (kc >> 1) + 32 : (kc >> 1); q = g_qn[128 + d]; k = g_kn[128 + d]; } else { q = 0.f; k = 0.f; }
      gp[c] = q; gp[256 + c] = k; }
    { const Bufs b = make_bufs<CH>(kargs(), 0); h1_rows(b, kargs()->in[2], CH, bid * 8 + wid, G * 8, lane); }
  }
  cg::this_grid().sync();
  { XcdBarrier p_ = xcd_barrier_post((unsigned*)(kargs()->ws + WS_BAR), bst); xbar.x = p_.x; }
  for (int chunk = 0; chunk < nchunk; ++chunk) {
    const int SL = (chunk * CH < NP) ? 4096 : 8192, nseq = CH / SL, NC = SL / 128;
#define MKB const Bufs b = make_bufs<CH>(kargs(), chunk)
    PHASE_BEGIN(run);
    if (run && PM(1)) for (int rep_ = 0; rep_ < DUP_P1; ++rep_) { MKB; WSL; pg8::Gemm g{b.H1O, WT(WS_WIN), CH, N_IN, 1024, 1024}; pg8::StaticOrder S; S.init(CH, N_IN, G, bid); EpiIn E{b, rep_ == 0}; pg8::gemm_phase(lds, g, S, E); }
    PHASE_BEGIN(run);
    if (run && PM(2)) {
      for (int rep_ = 0; rep_ < DUP_P2G; ++rep_) {
      if (PM(10)) { MKB; WSL; pg8::Gemm g{b.CQ, WT(WS_WUQ), CH, 2048, 384, 384}; pg8::StaticOrder S; S.init(CH, 2048, G, bid); EpiQ E{b}; pg8::gemm_phase(lds, g, S, E); }
      if (PM(11)) { MKB; WSL; pg8::Gemm g{b.CKV, WT(WS_WUKV), CH, 2048, 256, 256}; pg8::StaticOrder S; S.init(CH, 2048, G, bid); EpiKV E{b}; pg8::gemm_phase(lds, g, S, E); }
      }
      for (int rep_ = 0; rep_ < DUP_R1; ++rep_)
      if (PM(12)) for (int it = bid; it < CH / 32; it += G) { MKB; const int h = it & 3; ret_kv_item(b, it, lg2_of(kargs()->in[4], h), lg2_of(kargs()->in[5], h), ldsg); }
    }
    PHASE_BEGIN(run);
    if (run && PM(3)) {
      if (PM(13)) { MKB; TIDS; ret_scan(b, nseq, NC, kargs()->in[4], kargs()->in[5], bid * 512 + tid, G * 512); }
      const int vb = (G % 8 == 0) ? (bid % 8) * (G / 8) + bid / 8 : bid;
      const int nqb = SL / 256, nunits = nseq * 8 * nqb;
      for (int rep_ = 0; rep_ < DUP_ATTN; ++rep_)
      if (PM(14)) for (int uidx = vb; uidx < nunits; uidx += G) { MKB; const int qb = uidx % nqb, hh = (uidx / nqb) & 7, s = uidx / (nqb * 8);
        const size_t t0 = (size_t)s * SL;
        att::attn_unit(b.Q + (t0 + (size_t)qb * 256) * 1536 + hh * 192, b.K + t0 * 1536 + hh * 192, b.V + t0 * 1024 + hh * 128, b.H1O + (t0 + (size_t)qb * 256) * 1024 + hh * 128, SL, ldsg, lds); }
    }
    PHASE_BEGIN(run);
    if (run && PM(4)) { for (int rep_ = 0; rep_ < DUP_R3; ++rep_) for (int it = bid; it < CH / 32; it += G) { MKB; const int h = it & 3; ret_out_item(b, it, lg2_of(kargs()->in[4], h), lg2_of(kargs()->in[5], h), kargs()->in[6], ldsg); } }
    PHASE_BEGIN(run);
    if (run && PM(5)) for (int rep_ = 0; rep_ < DUP_P5; ++rep_) {
      { MKB; WSL; pg8::Gemm g{b.URET, WT(WS_WRO), CH, 1024, 1024, 1024}; pg8::StaticOrder S; S.init(CH, 1024, G, bid); EpiGate<0> E{b}; pg8::gemm_phase(lds, g, S, E); }
      { MKB; WSL; pg8::Gemm g{b.H1O, WT(WS_WMO), CH, 1024, 1024, 1024}; pg8::StaticOrder S; S.init(CH, 1024, G, bid); EpiGate<1> E{b}; pg8::gemm_phase(lds, g, S, E); }
    }
    PHASE_BEGIN(run);
    if (run && PM(6)) for (int rep_ = 0; rep_ < DUP_P69; ++rep_) { MKB; WSL; pg8::Gemm g{b.RV, WT(WS_WOUT), CH, 1024, 1024, 1024}; pg8::StaticOrder S; S.init(CH, 1024, G, bid); EpiOut E{b, rep_ == 0}; pg8::gemm_phase(lds, g, S, E); }
    PHASE_BEGIN(run);
    if (run && PM(7)) for (int rep_ = 0; rep_ < DUP_P7; ++rep_) { MKB; WSL; pg8::Gemm g{b.RG, WT(WS_WUP), CH, N_UP, 1024, 1024}; pg8::StaticOrder S; S.init(CH, N_UP, G, bid); EpiUp E{b}; pg8::gemm_phase(lds, g, S, E); }
    PHASE_BEGIN(run);
    if (run && PM(8)) for (int rep_ = 0; rep_ < DUP_P8; ++rep_) { MKB; TIDS; conv_gate(b, kargs()->in[18], kargs()->in[19], CH, bid, G, tid); }
    PHASE_BEGIN(run);
    if (run && PM(9)) {
      for (int rep_ = 0; rep_ < DUP_P69; ++rep_) { MKB; WSL; pg8::Gemm g{b.G, WT(WS_WDN), CH, 1024, DFF, DFF}; pg8::StaticOrder S; S.init(CH, 1024, G, bid); EpiDown E{b, rep_ == 0}; pg8::gemm_phase(lds, g, S, E); }
      if (chunk + 1 < nchunk) { TIDS; const Bufs nb = make_bufs<CH>(kargs(), chunk + 1); h1_rows(nb, kargs()->in[2], CH, bid * 8 + wid, G * 8, lane); }
    }
  }
}

extern "C" void kernel_launch(void* const* d_in, const int* in_sizes, int n_in, void* d_out, int out_size,
                              void* d_ws, size_t ws_size, hipStream_t stream) {
  static int grid_blocks = 0;
  if (!grid_blocks) {
    int dev = 0, cus = 0, per_cu = 0;
    (void)hipGetDevice(&dev);
    (void)hipDeviceGetAttribute(&cus, hipDeviceAttributeMultiprocessorCount, dev);
    (void)hipFuncSetAttribute((const void*)fwd_kernel<32768>, hipFuncAttributeMaxDynamicSharedMemorySize, LDS_BYTES);
    (void)hipFuncSetAttribute((const void*)fwd_kernel<16384>, hipFuncAttributeMaxDynamicSharedMemorySize, LDS_BYTES);
    (void)hipOccupancyMaxActiveBlocksPerMultiprocessor(&per_cu, fwd_kernel<32768>, 512, LDS_BYTES);
    if (per_cu < 1) per_cu = 1;
    grid_blocks = cus * per_cu;
    if (grid_blocks > 256) grid_blocks = 256;
  }
  Args a{};
  for (int i = 0; i < 21; ++i) a.in[i] = (const float*)d_in[i];
  a.out = (float*)d_out; a.ws = (unsigned char*)d_ws;
  const bool big = WS_PERM_END + (size_t)PT_END * 32768 <= ws_size;
  a.CH = big ? 32768 : 16384; a.ph_lo = 0; a.ph_hi = 0; a.pad = 0;
  void* args[] = {&a};
  hipError_t e = hipLaunchCooperativeKernel(big ? (void*)fwd_kernel<32768> : (void*)fwd_kernel<16384>, dim3(grid_blocks), dim3(512), args, LDS_BYTES, stream);
  if (e != hipSuccess) fprintf(stderr, "cooperative launch failed: %s (grid %d)\n", hipGetErrorString(e), grid_blocks);
}
```

```cpp
#include <hip/hip_runtime.h>
#include <hip/hip_cooperative_groups.h>
#include <cstdio>
#include <cstdint>
namespace cg = cooperative_groups;

#define LAS __attribute__((address_space(3)))
typedef unsigned short bf16_t;
typedef short bf16x8 __attribute__((ext_vector_type(8)));
typedef short s16x4 __attribute__((ext_vector_type(4)));
typedef float f32x4 __attribute__((ext_vector_type(4)));
typedef float f32x2 __attribute__((ext_vector_type(2)));
typedef float f32x16 __attribute__((ext_vector_type(16)));
typedef unsigned u32x4 __attribute__((ext_vector_type(4)));
typedef unsigned u32x2 __attribute__((ext_vector_type(2)));

constexpr int DM = 1024, NP = 32768, TT = 98304;
constexpr int N_IN = 5888, N_UP = 5632, DFF = 2816;
constexpr float EPS = 1e-6f;
constexpr int LDS_BYTES = 163840;
#ifndef DUP_ATTN
#define DUP_ATTN 1
#endif
#ifndef DUP_R1
#define DUP_R1 1
#endif
#ifndef DUP_R3
#define DUP_R3 1
#endif
#ifndef DUP_P5
#define DUP_P5 1
#endif
#ifndef DUP_P7
#define DUP_P7 1
#endif
#ifndef DUP_P8
#define DUP_P8 1
#endif
#ifndef DUP_P2G
#define DUP_P2G 1
#endif
#ifndef DUP_P0
#define DUP_P0 1
#endif
#ifndef DUP_P1
#define DUP_P1 1
#endif
#ifndef DUP_P69
#define DUP_P69 1
#endif
#ifndef DUP_SYNC
#define DUP_SYNC 1
#endif
#ifndef PMASK
#define PMASK 0xFFFFF
#endif
#define PM(k) ((PMASK >> (k)) & 1)

constexpr size_t al256(size_t x) { return (x + 255) / 256 * 256; }
constexpr size_t WS_WIN = 0;
constexpr size_t WS_WUQ = WS_WIN + (size_t)N_IN * 1024 * 2;
constexpr size_t WS_WUKV = WS_WUQ + (size_t)2048 * 384 * 2;
constexpr size_t WS_WRO = WS_WUKV + (size_t)2048 * 256 * 2;
constexpr size_t WS_WMO = WS_WRO + (size_t)1024 * 1024 * 2;
constexpr size_t WS_WOUT = WS_WMO + (size_t)1024 * 1024 * 2;
constexpr size_t WS_WUP = WS_WOUT + (size_t)1024 * 1024 * 2;
constexpr size_t WS_WDN = WS_WUP + (size_t)N_UP * 1024 * 2;
constexpr size_t WS_ROPE = WS_WDN + (size_t)1024 * DFF * 2;
constexpr size_t WS_SSQ = WS_ROPE + (size_t)8192 * 64 * 8;
constexpr size_t WS_GP = WS_SSQ + (size_t)30 * TT * 4;
constexpr size_t WS_BAR = al256(WS_GP + 2048);
constexpr size_t WS_PERM_END = al256(WS_BAR + 16384);
constexpr size_t PT_H1O = 0, PT_RG = 2048, PT_RQ = 4096, PT_RK = 5120, PT_RV = 6144, PT_GR = 8192, PT_GA = 10240, PT_CQ = 12288, PT_CKV = 13056,
                 PT_KR = 13568, PT_Q = 13696, PT_K = 16768, PT_V = 19840, PT_URET = 21888, PT_KV = 23936, PT_END = 28032;
constexpr size_t PT_UR = PT_RQ, PT_G = PT_RQ + 11264;
static_assert(PT_G + 5632 <= PT_END, "ffn overlay");

struct Args { const float* in[21]; float* out; unsigned char* ws; int CH; int ph_lo; int ph_hi; int pad; };

__device__ __forceinline__ unsigned cvt_pk(float lo, float hi) { unsigned r; asm volatile("v_cvt_pk_bf16_f32 %0, %1, %2" : "=v"(r) : "v"(lo), "v"(hi)); return r; }
__device__ __forceinline__ float bflo(unsigned w) { return __uint_as_float(w << 16); }
__device__ __forceinline__ float bfhi(unsigned w) { return __uint_as_float(w & 0xffff0000u); }
__device__ __forceinline__ void st8(bf16_t* p, f32x4 a, f32x4 b) { u32x4 w = {cvt_pk(a[0], a[1]), cvt_pk(a[2], a[3]), cvt_pk(b[0], b[1]), cvt_pk(b[2], b[3])}; *(u32x4*)p = w; }
__device__ __forceinline__ void ld8(const bf16_t* p, f32x4& a, f32x4& b) { u32x4 w = *(const u32x4*)p; a = (f32x4){bflo(w.x), bfhi(w.x), bflo(w.y), bfhi(w.y)}; b = (f32x4){bflo(w.z), bfhi(w.z), bflo(w.w), bfhi(w.w)}; }
__device__ __forceinline__ float sigm(float x) { return __builtin_amdgcn_rcpf(1.f + __builtin_amdgcn_exp2f(x * -1.4426950408889634f)); }
typedef __bf16 bf16x2_t __attribute__((ext_vector_type(2)));
__device__ __forceinline__ unsigned cvt_pk_s(float lo, float hi) { f32x2 v = {lo, hi}; bf16x2_t b = __builtin_convertvector(v, bf16x2_t); return __builtin_bit_cast(unsigned, b); }
__device__ __forceinline__ void st8_s(bf16_t* p, f32x4 a, f32x4 b) { u32x4 w = {cvt_pk_s(a[0], a[1]), cvt_pk_s(a[2], a[3]), cvt_pk_s(b[0], b[1]), cvt_pk_s(b[2], b[3])}; *(u32x4*)p = w; }
__device__ __forceinline__ float wave_sum(float v) {
#pragma unroll
  for (int o = 1; o < 64; o <<= 1) v += __shfl_xor(v, o);
  return v;
}
__device__ __forceinline__ float dot4(f32x4 a) { return (a[0] * a[0] + a[1] * a[1]) + (a[2] * a[2] + a[3] * a[3]); }
__device__ __forceinline__ void lds_barrier() { asm volatile("s_waitcnt lgkmcnt(0)" ::: "memory"); __builtin_amdgcn_s_barrier(); asm volatile("" ::: "memory"); }

struct Bufs {
  bf16_t *H1O, *RG, *RQ, *RK, *RV, *GR, *GA, *CQ, *CKV, *KR, *Q, *K, *V, *URET, *KV, *UR, *G;
  const float* rope; float *ssq_cq, *ssq_ckv, *ssq_kr, *ssq_x1; const float *gqp, *gkp;
  const float *xp, *xs; float* out;
  int g0, slm;
};
__device__ __forceinline__ const float* xrow(const Bufs& b, int g) { return g < NP ? b.xp + (size_t)g * DM : b.xs + (size_t)(g - NP) * DM; }

namespace pg8 {
constexpr int BM = 256, BK = 64, HALF = 128, HTB = HALF * BK * 2, STAGE_BYTES = 8 * HTB, NXCD = 8, WGM = 8;
__host__ __device__ __forceinline__ int lds_byte(int r, int c) { const int st = (r >> 4) * 2 + (c >> 5), rr = r & 15, cc = c & 31, ob = rr * 64 + cc * 2; return st * 1024 + (ob ^ (((ob >> 9) & 1) << 5)); }
__host__ __device__ __forceinline__ void stage_rc(int b, int& R, int& C) { const int st = b / 1024, sb = b % 1024, swz = sb ^ (((sb >> 9) & 1) << 5); R = (st >> 1) * 16 + swz / 64; C = (st & 1) * 32 + (swz % 64) / 2; }
__host__ __device__ __forceinline__ int perm32(int rho) { const int n = rho >> 4, i = rho & 15; return 8 * (i >> 2) + 4 * n + (i & 3); }
struct Unit { int pm, pn; };
struct Gemm { const bf16_t* A; const bf16_t* Bt; int M, N, K, lda; };
struct StaticOrder {
  int nM, nN, nwg, G, c;
  __device__ void init(int M, int N, int G_, int c_) { nM = M / BM; nN = N / BM; nwg = nM * nN; G = G_; c = c_; }
  __device__ bool next(int i, Unit& u) const {
    const long L = (long)i * G + c; if (L >= nwg) return false;
    int wgid = (int)L; { const int q = nwg / NXCD, r = nwg % NXCD, xcd = wgid % NXCD, off = wgid / NXCD; wgid = (xcd < r ? xcd * (q + 1) : r * (q + 1) + (xcd - r) * q) + off; }
    const int nig = WGM * nN, gid = wgid / nig, fm = gid * WGM, gsz = (nM - fm) < WGM ? (nM - fm) : WGM;
    u.pm = fm + ((wgid % nig) % gsz); u.pn = (wgid % nig) / gsz; return true;
  }
};

template <class Epi, class Sched>
__device__ __forceinline__ void gemm_phase(LAS unsigned char* lds, const Gemm g, const Sched& S, const Epi& E) {
  constexpr bool ALIGN_EPI = true;
  int tid_ = threadIdx.x; asm volatile("" : "+v"(tid_));
  const int tid = tid_, wid = __builtin_amdgcn_readfirstlane(tid >> 6), lane = tid & 63, wr = wid >> 2, wc = wid & 3, fr = lane & 15, fq = lane >> 4;
  int K = g.K; asm volatile("" : "+s"(K)); const int nt = K / BK, lda = g.lda;
  unsigned voffA[2], voffB[2];
#pragma unroll
  for (int i = 0; i < 2; ++i) { int R, C; stage_rc(tid * 16 + i * 8192, R, C); const int Rb = (R & ~31) + perm32(R & 31);
    voffA[i] = (unsigned)(R * lda + C) * 2u; voffB[i] = (unsigned)(Rb * K + C) * 2u; }
  const size_t kstep = (size_t)(BK * 2);
  const size_t hstepA = (size_t)HALF * lda * 2, tstepA = 2 * hstepA;
  const size_t hstepB = (size_t)HALF * K * 2, tstepB = 2 * hstepB;
  const unsigned ldsw = (unsigned)wid * 1024u;
  const int aoff = lds_byte(wr * 64 + fr, fq * 8), boff = lds_byte(wc * 32 + fr, fq * 8);
#define PG8_SA(b, h) (((b) * 2 + (h)) * HTB)
#define PG8_SB(b, h) ((4 + (b) * 2 + (h)) * HTB)
#define PG8_STAGE(bufoff, gbase, voff) do { _Pragma("unroll") for (int _i = 0; _i < 2; ++_i) \
    __builtin_amdgcn_global_load_lds((const unsigned*)((const char*)(gbase) + (voff)[_i]), (LAS unsigned*)(lds + (bufoff) + ldsw + _i * 8192), 16, 0, 0); } while (0)
#define PG8_LDA(dst, b, h) do { _Pragma("unroll") for (int m = 0; m < 4; ++m) _Pragma("unroll") for (int k = 0; k < 2; ++k) dst[m][k] = *(const LAS bf16x8*)(lds + PG8_SA(b, h) + aoff + m * 2048 + k * 1024); } while (0)
#define PG8_LDB(dst, b, h) do { _Pragma("unroll") for (int n = 0; n < 2; ++n) _Pragma("unroll") for (int k = 0; k < 2; ++k) dst[n][k] = *(const LAS bf16x8*)(lds + PG8_SB(b, h) + boff + n * 2048 + k * 1024); } while (0)
#define PG8_MMA(ai, bj, At, Bt) do { __builtin_amdgcn_s_setprio(1); _Pragma("unroll") for (int m = 0; m < 4; ++m) _Pragma("unroll") for (int n = 0; n < 2; ++n) _Pragma("unroll") for (int k = 0; k < 2; ++k) \
    acc[ai][bj][m][n] = __builtin_amdgcn_mfma_f32_16x16x32_bf16(Bt[n][k], At[m][k], acc[ai][bj][m][n], 0, 0, 0); __builtin_amdgcn_s_setprio(0); } while (0)
#define PG8_WAIT_V(n) asm volatile("s_waitcnt vmcnt(" #n ")" ::: "memory")
#define PG8_WAIT_L(n) asm volatile("s_waitcnt lgkmcnt(" #n ")" ::: "memory")
#define PG8_BAR __builtin_amdgcn_s_barrier()
#define PG8_SCHED __builtin_amdgcn_sched_barrier(0)
  Unit cur, nxt; int ui = 0;
  if (!S.next(0, cur)) return;
  f32x4 acc[2][2][4][2];
#pragma unroll
  for (int a = 0; a < 2; ++a)
#pragma unroll
    for (int b = 0; b < 2; ++b)
#pragma unroll
      for (int m = 0; m < 4; ++m)
#pragma unroll
        for (int n = 0; n < 2; ++n) acc[a][b][m][n] = (f32x4){0.f, 0.f, 0.f, 0.f};
  bf16x8 At[4][2], B0[2][2], B1[2][2];
  const char* cA = (const char*)g.A + (size_t)cur.pm * tstepA; const char* cB = (const char*)g.Bt + (size_t)cur.pn * tstepB;
  PG8_STAGE(PG8_SB(0, 0), cB, voffB); PG8_STAGE(PG8_SB(0, 1), cB + hstepB, voffB); PG8_STAGE(PG8_SA(0, 0), cA, voffA); PG8_STAGE(PG8_SA(0, 1), cA + hstepA, voffA);
  if (wr == 1) PG8_BAR;
  PG8_WAIT_V(2); PG8_BAR;
  PG8_STAGE(PG8_SB(1, 0), cB + kstep, voffB); PG8_STAGE(PG8_SA(1, 0), cA + kstep, voffA); PG8_STAGE(PG8_SB(1, 1), cB + hstepB + kstep, voffB);
  PG8_WAIT_V(6); PG8_BAR;
  for (;;) {
    const bool has_next = S.next(ui + 1, nxt);
    const char* nA = has_next ? (const char*)g.A + (size_t)nxt.pm * tstepA : cA; const char* nB = has_next ? (const char*)g.Bt + (size_t)nxt.pn * tstepB : cB;
    for (int t = 0; t < nt; t += 2) {
      const bool last = (t == nt - 2);
      const char* a1 = cA + (size_t)(t + 1) * kstep;
      const char* a2 = last ? nA : cA + (size_t)(t + 2) * kstep; const char* b2 = last ? nB : cB + (size_t)(t + 2) * kstep;
      const char* a3 = a2 + kstep; const char* b3 = b2 + kstep;
      PG8_LDB(B0, 0, 0); PG8_LDB(B1, 0, 1); PG8_SCHED; PG8_LDA(At, 0, 0); PG8_STAGE(PG8_SA(1, 1), a1 + hstepA, voffA);
      PG8_WAIT_V(8); PG8_WAIT_L(0); PG8_BAR; PG8_MMA(0, 0, At, B0); PG8_MMA(0, 1, At, B1); PG8_BAR; PG8_SCHED;
      PG8_LDA(At, 0, 1); PG8_STAGE(PG8_SB(0, 0), b2, voffB); PG8_STAGE(PG8_SB(0, 1), b2 + hstepB, voffB); PG8_STAGE(PG8_SA(0, 0), a2, voffA);
      PG8_WAIT_V(8); PG8_WAIT_L(0); PG8_BAR; PG8_MMA(1, 0, At, B0); PG8_MMA(1, 1, At, B1); PG8_BAR; PG8_SCHED;
      PG8_LDB(B0, 1, 0); PG8_LDB(B1, 1, 1); PG8_SCHED; PG8_LDA(At, 1, 0); PG8_STAGE(PG8_SA(0, 1), a2 + hstepA, voffA);
      PG8_WAIT_V(8); PG8_WAIT_L(0); PG8_BAR; PG8_MMA(0, 0, At, B0); PG8_MMA(0, 1, At, B1); PG8_BAR; PG8_SCHED;
      PG8_LDA(At, 1, 1); PG8_STAGE(PG8_SB(1, 0), b3, voffB); PG8_STAGE(PG8_SB(1, 1), b3 + hstepB, voffB); PG8_STAGE(PG8_SA(1, 0), a3, voffA);
      PG8_WAIT_V(8); PG8_WAIT_L(0); PG8_BAR; PG8_MMA(1, 0, At, B0); PG8_MMA(1, 1, At, B1); PG8_BAR; PG8_SCHED;
    }
    if constexpr (ALIGN_EPI) { if (wr == 0) PG8_BAR; }
    { int fr2 = fr, fq2 = fq; asm volatile("" : "+v"(fr2), "+v"(fq2)); E(acc, cur, wr, wc, fr2, fq2, lds + STAGE_BYTES); }
    if (!has_next) break;
#pragma unroll
    for (int a = 0; a < 2; ++a)
#pragma unroll
      for (int b = 0; b < 2; ++b)
#pragma unroll
        for (int m = 0; m < 4; ++m)
#pragma unroll
          for (int n = 0; n < 2; ++n) acc[a][b][m][n] = (f32x4){0.f, 0.f, 0.f, 0.f};
    cur = nxt; cA = nA; cB = nB; ++ui;
    if constexpr (ALIGN_EPI) { if (wr == 1) PG8_BAR; }
  }
  PG8_WAIT_V(0);
  if constexpr (!ALIGN_EPI) { if (wr == 0) PG8_BAR; }
  PG8_BAR;
#undef PG8_SA
#undef PG8_SB
#undef PG8_STAGE
#undef PG8_LDA
#undef PG8_LDB
#undef PG8_MMA
#undef PG8_WAIT_V
#undef PG8_WAIT_L
#undef PG8_BAR
#undef PG8_SCHED
}
}
using pg8::Unit;

#define SBAR0() __builtin_amdgcn_sched_barrier(0)
#define EPI_ARGS const f32x4 (&acc)[2][2][4][2], const Unit& u, int wr, int wc, int fr, int fq, LAS unsigned char* scr
#define FOR_AI_M _Pragma("unroll") for (int ai = 0; ai < 2; ++ai) if ((__builtin_amdgcn_sched_barrier(0), true)) _Pragma("unroll") for (int m = 0; m < 4; ++m)

__device__ __forceinline__ void rope4(f32x4& v0, f32x4& v1, f32x4 t0, f32x4 t1) {
  f32x4 o0 = {v0[0] * t0[0] - v0[1] * t0[1], v0[0] * t0[1] + v0[1] * t0[0], v0[2] * t0[2] - v0[3] * t0[3], v0[2] * t0[3] + v0[3] * t0[2]};
  f32x4 o1 = {v1[0] * t1[0] - v1[1] * t1[1], v1[0] * t1[1] + v1[1] * t1[0], v1[2] * t1[2] - v1[3] * t1[3], v1[2] * t1[3] + v1[3] * t1[2]};
  v0 = o0; v1 = o1;
}

struct EpiIn {
  Bufs b; bool at;
  __device__ __forceinline__ void rope_store(const f32x4 (&acc)[2][2][4][2], bf16_t* dst, float sc, int hsel, int rbase, int wc, int fq) const {
    const int c0 = wc * 32 + fq * 8, i0 = wc * 16 + fq * 4;
    FOR_AI_M { const int row = rbase + ai * 128 + m * 16, pos = (b.g0 + row) & b.slm;
      const f32x4* tp = (const f32x4*)(b.rope + ((size_t)pos * 64 + i0) * 2); const f32x4 t0 = tp[0], t1 = tp[1];
#pragma unroll
      for (int bj = 0; bj < 2; ++bj) { f32x4 v0 = acc[ai][bj][m][0], v1 = acc[ai][bj][m][1]; rope4(v0, v1, t0, t1);
        st8(dst + (size_t)row * 512 + (hsel * 2 + bj) * 128 + c0, v0 * sc, v1 * sc); } }
  }
  template <int ACT> __device__ __forceinline__ void plain_store(const f32x4 (&acc)[2][2][4][2], bf16_t* dst, int cbase, int rbase) const {
    FOR_AI_M { const int row = rbase + ai * 128 + m * 16;
#pragma unroll
      for (int bj = 0; bj < 2; ++bj) { f32x4 v0 = acc[ai][bj][m][0], v1 = acc[ai][bj][m][1];
        if (ACT == 1) {
#pragma unroll
          for (int e = 0; e < 4; ++e) { v0[e] = v0[e] * sigm(v0[e]); v1[e] = v1[e] * sigm(v1[e]); } }
        if (ACT == 2) {
#pragma unroll
          for (int e = 0; e < 4; ++e) { v0[e] = sigm(v0[e]); v1[e] = sigm(v1[e]); } }
        if (ACT == 0) st8(dst + (size_t)row * 1024 + cbase + bj * 128, v0, v1); else st8_s(dst + (size_t)row * 1024 + cbase + bj * 128, v0, v1); } }
  }
  __device__ __forceinline__ void ssq_store(const f32x4 (&acc)[2][2][4][2], bf16_t* dst, int ld, float* sq, int ns, int slot, int rbase, int c0, int fq) const {
    FOR_AI_M { const int row = rbase + ai * 128 + m * 16; float s = 0.f;
#pragma unroll
      for (int bj = 0; bj < 2; ++bj) { const f32x4 v0 = acc[ai][bj][m][0], v1 = acc[ai][bj][m][1]; s += dot4(v0) + dot4(v1); st8(dst + (size_t)row * ld + bj * 128 + c0, v0, v1); }
      s += __shfl_xor(s, 16); s += __shfl_xor(s, 32); if (fq == 0 && at) sq[(size_t)(b.g0 + row) * ns + slot] = s; }
  }
  __device__ __forceinline__ void operator()(EPI_ARGS) const {
    const int pn = u.pn, rbase = u.pm * 256 + wr * 64 + fr, c0 = wc * 32 + fq * 8;
    if (pn < 2) rope_store(acc, b.RQ, 1.f, pn, rbase, wc, fq);
    else if (pn < 4) rope_store(acc, b.RK, 0.08838834764831845f, pn - 2, rbase, wc, fq);
    else if (pn < 8) plain_store<0>(acc, b.RV, (pn - 4) * 256 + c0, rbase);
    else if (pn < 12) plain_store<1>(acc, b.RG, (pn - 8) * 256 + c0, rbase);
    else if (pn < 16) plain_store<2>(acc, b.GR, (pn - 12) * 256 + c0, rbase);
    else if (pn < 20) plain_store<2>(acc, b.GA, (pn - 16) * 256 + c0, rbase);
    else if (pn == 20) ssq_store(acc, b.CQ, 384, b.ssq_cq, 8, wc, rbase, c0, fq);
    else if (pn == 22) ssq_store(acc, b.CKV, 256, b.ssq_ckv, 4, wc, rbase, c0, fq);
    else {
      FOR_AI_M { const int row = rbase + ai * 128 + m * 16, pos = (b.g0 + row) & b.slm;
        { const f32x4 v0 = acc[ai][0][m][0], v1 = acc[ai][0][m][1]; float s = dot4(v0) + dot4(v1); st8(b.CQ + (size_t)row * 384 + 256 + c0, v0, v1);
          s += __shfl_xor(s, 16); s += __shfl_xor(s, 32); if (fq == 0 && at) b.ssq_cq[(size_t)(b.g0 + row) * 8 + 4 + wc] = s; }
        if (wc < 2) { f32x4 v0 = acc[ai][1][m][0], v1 = acc[ai][1][m][1]; const int j0 = wc * 16 + fq * 4;
          const f32x2* tp = (const f32x2*)(b.rope + ((size_t)pos * 64 + 2 * j0) * 2); const f32x2 a0 = tp[0], a1 = tp[2], a2 = tp[4], a3 = tp[6];
          rope4(v0, v1, (f32x4){a0[0], a0[1], a1[0], a1[1]}, (f32x4){a2[0], a2[1], a3[0], a3[1]});
          float s = dot4(v0) + dot4(v1); st8(b.KR + (size_t)row * 64 + c0, v0, v1);
          s += __shfl_xor(s, 16); s += __shfl_xor(s, 32); if (fq == 0 && at) b.ssq_kr[(size_t)(b.g0 + row) * 2 + wc] = s; } }
    }
  }
};

__device__ __forceinline__ void xwave_rowsum(float (&part)[8], int wr, int wc, int fr, int fq, LAS unsigned char* scr) {
  LAS float* red = (LAS float*)scr;
  if (fq == 0) {
#pragma unroll
    for (int i = 0; i < 8; ++i) red[((wr * 4 + wc) * 8 + i) * 16 + fr] = part[i];
  }
  lds_barrier();
#pragma unroll
  for (int i = 0; i < 8; ++i) part[i] = (red[((wr * 4 + 0) * 8 + i) * 16 + fr] + red[((wr * 4 + 1) * 8 + i) * 16 + fr]) + (red[((wr * 4 + 2) * 8 + i) * 16 + fr] + red[((wr * 4 + 3) * 8 + i) * 16 + fr]);
}

struct EpiQ {
  Bufs b;
  __device__ __forceinline__ void operator()(EPI_ARGS) const {
    const int head = u.pn, rbase = u.pm * 256 + wr * 64 + fr, c0 = wc * 32 + fq * 8;
    float part[8];
    FOR_AI_M { float s = 0.f;
#pragma unroll
      for (int bj = 0; bj < 2; ++bj) s += dot4(acc[ai][bj][m][0]) + dot4(acc[ai][bj][m][1]);
      s += __shfl_xor(s, 16); s += __shfl_xor(s, 32); part[ai * 4 + m] = s; }
    xwave_rowsum(part, wr, wc, fr, fq, scr);
    const float* gqp = b.gqp; asm volatile("" : "+s"(gqp));
    const f32x4 g0 = *(const f32x4*)(gqp + c0), g1 = *(const f32x4*)(gqp + c0 + 4), h0 = *(const f32x4*)(gqp + 128 + c0), h1 = *(const f32x4*)(gqp + 128 + c0 + 4);
    FOR_AI_M { const int i = ai * 4 + m, row = rbase + ai * 128 + m * 16, pos = (b.g0 + row) & b.slm;
      const f32x4* sp = (const f32x4*)(b.ssq_cq + (size_t)(b.g0 + row) * 8); const f32x4 s0 = sp[0], s1 = sp[1];
      const float r1 = rsqrtf((((s0[0] + s0[1]) + (s0[2] + s0[3])) + ((s1[0] + s1[1]) + (s1[2] + s1[3]))) * (1.f / 384.f) + EPS);
      const float f = r1 * rsqrtf(r1 * r1 * part[i] * (1.f / 192.f) + EPS) * 0.10411754002f;
      bf16_t* qp = b.Q + (size_t)row * 1536 + head * 192;
      st8(qp + c0, acc[ai][0][m][0] * g0 * f, acc[ai][0][m][1] * g1 * f);
      if (wc < 2) { f32x4 v0 = acc[ai][1][m][0] * h0 * f, v1 = acc[ai][1][m][1] * h1 * f; const int j0 = wc * 16 + fq * 4;
        const f32x2* tp = (const f32x2*)(b.rope + ((size_t)pos * 64 + 2 * j0) * 2); const f32x2 a0 = tp[0], a1 = tp[2], a2 = tp[4], a3 = tp[6];
        rope4(v0, v1, (f32x4){a0[0], a0[1], a1[0], a1[1]}, (f32x4){a2[0], a2[1], a3[0], a3[1]});
        st8(qp + 128 + c0, v0, v1); } }
  }
};

struct EpiKV {
  Bufs b;
  __device__ __forceinline__ void operator()(EPI_ARGS) const {
    const int head = u.pn, rbase = u.pm * 256 + wr * 64 + fr, c0 = wc * 32 + fq * 8;
    float part[8], rs[8];
    FOR_AI_M { const int row = rbase + ai * 128 + m * 16; { const f32x4 s0 = *(const f32x4*)(b.ssq_ckv + (size_t)(b.g0 + row) * 4); rs[ai * 4 + m] = rsqrtf(((s0[0] + s0[1]) + (s0[2] + s0[3])) * (1.f / 256.f) + EPS); }
      float s = dot4(acc[ai][0][m][0]) + dot4(acc[ai][0][m][1]);
      s += __shfl_xor(s, 16); s += __shfl_xor(s, 32); part[ai * 4 + m] = s; }
    xwave_rowsum(part, wr, wc, fr, fq, scr);
    const float* gkp = b.gkp; asm volatile("" : "+s"(gkp));
    const f32x4 g0 = *(const f32x4*)(gkp + c0), g1 = *(const f32x4*)(gkp + c0 + 4);
    const int kc0 = (wc * 4 + fq) * 4; const f32x4 gr = *(const f32x4*)(gkp + 128 + kc0);
    FOR_AI_M { const int i = ai * 4 + m, row = rbase + ai * 128 + m * 16, pos = (b.g0 + row) & b.slm;
      const float r1 = rs[i], rsk = rsqrtf((r1 * r1 * part[i] + (b.ssq_kr[(size_t)(b.g0 + row) * 2] + b.ssq_kr[(size_t)(b.g0 + row) * 2 + 1])) * (1.f / 192.f) + EPS), f = r1 * rsk;
      bf16_t* kp = b.K + (size_t)row * 1536 + head * 192;
      st8(kp + c0, acc[ai][0][m][0] * g0 * f, acc[ai][0][m][1] * g1 * f);
      st8(b.V + (size_t)row * 1024 + head * 128 + c0, acc[ai][1][m][0] * r1, acc[ai][1][m][1] * r1);
      const u32x2 w = *(const u32x2*)(b.KR + (size_t)row * 64 + kc0);
      const float x0 = bflo(w.x) * gr[0], y0 = bfhi(w.x) * gr[1], x1 = bflo(w.y) * gr[2], y1 = bfhi(w.y) * gr[3];
      const f32x2* tp = (const f32x2*)(b.rope + ((size_t)pos * 64 + kc0) * 2); const f32x2 a0 = tp[0], a1 = tp[2];
      u32x2 o; o.x = cvt_pk((x0 * a0[0] - y0 * a0[1]) * rsk, (x0 * a0[1] + y0 * a0[0]) * rsk); o.y = cvt_pk((x1 * a1[0] - y1 * a1[1]) * rsk, (x1 * a1[1] + y1 * a1[0]) * rsk);
      *(u32x2*)(kp + 128 + kc0) = o; }
  }
};

template <int mode> struct EpiGate {
  Bufs b;
  __device__ __forceinline__ void operator()(EPI_ARGS) const {
    const int rbase = u.pm * 256 + wr * 64 + fr, c0 = u.pn * 256 + wc * 32 + fq * 8; const bf16_t* gate = mode ? b.GA : b.GR; bf16_t* mg = b.RV;
#pragma unroll
    for (int ai = 0; ai < 2; ++ai) {
      SBAR0();
      u32x4 gt[4][2], pv[4][2];
#pragma unroll
      for (int m = 0; m < 4; ++m)
#pragma unroll
        for (int bj = 0; bj < 2; ++bj) { const size_t idx = (size_t)(rbase + ai * 128 + m * 16) * 1024 + c0 + bj * 128; gt[m][bj] = *(const u32x4*)(gate + idx); if (mode) pv[m][bj] = *(const u32x4*)(mg + idx); }
#pragma unroll
      for (int m = 0; m < 4; ++m)
#pragma unroll
        for (int bj = 0; bj < 2; ++bj) { const size_t idx = (size_t)(rbase + ai * 128 + m * 16) * 1024 + c0 + bj * 128; const u32x4 g = gt[m][bj];
          f32x4 v0 = acc[ai][bj][m][0] * (f32x4){bflo(g.x), bfhi(g.x), bflo(g.y), bfhi(g.y)}, v1 = acc[ai][bj][m][1] * (f32x4){bflo(g.z), bfhi(g.z), bflo(g.w), bfhi(g.w)};
          if (mode) { const u32x4 p = pv[m][bj]; v0 += (f32x4){bflo(p.x), bfhi(p.x), bflo(p.y), bfhi(p.y)}; v1 += (f32x4){bflo(p.z), bfhi(p.z), bflo(p.w), bfhi(p.w)}; }
          st8(mg + idx, v0, v1); }
    }
  }
};

struct EpiOut {
  Bufs b; bool at;
  __device__ __forceinline__ void operator()(EPI_ARGS) const {
    const int rbase = u.pm * 256 + wr * 64 + fr, c0 = u.pn * 256 + wc * 32 + fq * 8;
#pragma unroll
    for (int ai = 0; ai < 2; ++ai) {
      SBAR0();
      f32x4 xv[4][2][2];
#pragma unroll
      for (int m = 0; m < 4; ++m) { const float* xr = xrow(b, b.g0 + rbase + ai * 128 + m * 16);
#pragma unroll
        for (int bj = 0; bj < 2; ++bj) { xv[m][bj][0] = *(const f32x4*)(xr + c0 + bj * 128); xv[m][bj][1] = *(const f32x4*)(xr + c0 + bj * 128 + 4); } }
#pragma unroll
      for (int m = 0; m < 4; ++m) { const int row = rbase + ai * 128 + m * 16, g = b.g0 + row; float s = 0.f;
#pragma unroll
        for (int bj = 0; bj < 2; ++bj) { const int c = c0 + bj * 128; const f32x4 v0 = acc[ai][bj][m][0] + xv[m][bj][0], v1 = acc[ai][bj][m][1] + xv[m][bj][1];
          st8(b.RG + (size_t)row * 1024 + c, v0, v1); s += dot4(v0) + dot4(v1); }
        s += __shfl_xor(s, 16); s += __shfl_xor(s, 32); if (fq == 0 && at) b.ssq_x1[(size_t)g * 16 + u.pn * 4 + wc] = s; }
    }
  }
};

struct EpiUp {
  Bufs b;
  __device__ __forceinline__ void operator()(EPI_ARGS) const {
    const int rbase = u.pm * 256 + wr * 64 + fr, c0 = u.pn * 256 + wc * 32 + fq * 8;
    FOR_AI_M { const int row = rbase + ai * 128 + m * 16; const f32x4* sp = (const f32x4*)(b.ssq_x1 + (size_t)(b.g0 + row) * 16); const f32x4 q0 = sp[0], q1 = sp[1], q2 = sp[2], q3 = sp[3];
      const float r2 = rsqrtf(((((q0[0] + q0[1]) + (q0[2] + q0[3])) + ((q1[0] + q1[1]) + (q1[2] + q1[3]))) + (((q2[0] + q2[1]) + (q2[2] + q2[3])) + ((q3[0] + q3[1]) + (q3[2] + q3[3])))) * (1.f / 1024.f) + EPS);
#pragma unroll
      for (int bj = 0; bj < 2; ++bj) st8(b.UR + (size_t)row * N_UP + c0 + bj * 128, acc[ai][bj][m][0] * r2, acc[ai][bj][m][1] * r2); }
  }
};

struct EpiDown {
  Bufs b; bool at;
  __device__ __forceinline__ void operator()(EPI_ARGS) const {
    const int rbase = u.pm * 256 + wr * 64 + fr, c0 = u.pn * 256 + wc * 32 + fq * 8;
#pragma unroll
    for (int ai = 0; ai < 2; ++ai) {
      SBAR0();
      u32x4 xv[4][2];
#pragma unroll
      for (int m = 0; m < 4; ++m)
#pragma unroll
        for (int bj = 0; bj < 2; ++bj) xv[m][bj] = *(const u32x4*)(b.RG + (size_t)(rbase + ai * 128 + m * 16) * 1024 + c0 + bj * 128);
      if (at) {
#pragma unroll
        for (int m = 0; m < 4; ++m) { float* orow = b.out + (size_t)(b.g0 + rbase + ai * 128 + m * 16) * DM;
#pragma unroll
          for (int bj = 0; bj < 2; ++bj) { const int c = c0 + bj * 128; const u32x4 p = xv[m][bj];
            *(f32x4*)(orow + c) = (f32x4){bflo(p.x), bfhi(p.x), bflo(p.y), bfhi(p.y)} + acc[ai][bj][m][0]; *(f32x4*)(orow + c + 4) = (f32x4){bflo(p.z), bfhi(p.z), bflo(p.w), bfhi(p.w)} + acc[ai][bj][m][1]; } }
      }
    }
  }
};

#define SBAR() __builtin_amdgcn_sched_barrier(0)
__device__ __forceinline__ int crow(int r, int hi) { return (r & 3) + 8 * (r >> 2) + 4 * hi; }
__device__ __forceinline__ int v_st(int k, int c) { const int kk = (k & ~0xC) | ((k & 4) << 1) | ((k & 8) >> 1); return ((kk >> 3) * 4 + (c >> 5)) * 512 + ((kk & 7) * 32 + (c & 31)) * 2; }
__device__ __forceinline__ int v_rd_base(int lane) { return ((lane & 3) << 3) | (((lane >> 2) & 3) << 6) | (((lane >> 4) & 1) << 5) | (((lane >> 5) & 1) << 8); }
constexpr int v_rd_off(int d0, int ks, int half) { return d0 * 512 + ks * 4096 + half * 2048; }
template <int OFF> __device__ __forceinline__ s16x4 tr_read(int vb) {
  s16x4 r; asm volatile("ds_read_b64_tr_b16 %0, %1 offset:%2" : "=&v"(r) : "v"(vb), "i"(OFF) : "memory"); return r;
}
#define PKLH(L, H) (bf16x8){L[0], L[1], L[2], L[3], H[0], H[1], H[2], H[3]}
template <int D0> __device__ __forceinline__ void pv_one(f32x16& od, int vb, bf16x8 pa0, bf16x8 pa1, bf16x8 pa2, bf16x8 pa3) {
  const s16x4 l0 = tr_read<v_rd_off(D0, 0, 0)>(vb), h0 = tr_read<v_rd_off(D0, 0, 1)>(vb), l1 = tr_read<v_rd_off(D0, 1, 0)>(vb), h1 = tr_read<v_rd_off(D0, 1, 1)>(vb);
  const s16x4 l2 = tr_read<v_rd_off(D0, 2, 0)>(vb), h2 = tr_read<v_rd_off(D0, 2, 1)>(vb), l3 = tr_read<v_rd_off(D0, 3, 0)>(vb), h3 = tr_read<v_rd_off(D0, 3, 1)>(vb);
  asm volatile("s_waitcnt lgkmcnt(0)" ::: "memory"); SBAR();
  od = __builtin_amdgcn_mfma_f32_32x32x16_bf16(pa0, PKLH(l0, h0), od, 0, 0, 0);
  od = __builtin_amdgcn_mfma_f32_32x32x16_bf16(pa1, PKLH(l1, h1), od, 0, 0, 0);
  od = __builtin_amdgcn_mfma_f32_32x32x16_bf16(pa2, PKLH(l2, h2), od, 0, 0, 0);
  od = __builtin_amdgcn_mfma_f32_32x32x16_bf16(pa3, PKLH(l3, h3), od, 0, 0, 0);
}
template <int D0> __device__ __forceinline__ void pv_issue(s16x4 (&t)[8], int vb) {
  t[0] = tr_read<v_rd_off(D0, 0, 0)>(vb); t[1] = tr_read<v_rd_off(D0, 0, 1)>(vb); t[2] = tr_read<v_rd_off(D0, 1, 0)>(vb); t[3] = tr_read<v_rd_off(D0, 1, 1)>(vb);
  t[4] = tr_read<v_rd_off(D0, 2, 0)>(vb); t[5] = tr_read<v_rd_off(D0, 2, 1)>(vb); t[6] = tr_read<v_rd_off(D0, 3, 0)>(vb); t[7] = tr_read<v_rd_off(D0, 3, 1)>(vb);
}
__device__ __forceinline__ void pv_mma(f32x16& od, const s16x4 (&t)[8], bf16x8 pa0, bf16x8 pa1, bf16x8 pa2, bf16x8 pa3) {
  od = __builtin_amdgcn_mfma_f32_32x32x16_bf16(pa0, PKLH(t[0], t[1]), od, 0, 0, 0);
  od = __builtin_amdgcn_mfma_f32_32x32x16_bf16(pa1, PKLH(t[2], t[3]), od, 0, 0, 0);
  od = __builtin_amdgcn_mfma_f32_32x32x16_bf16(pa2, PKLH(t[4], t[5]), od, 0, 0, 0);
  od = __builtin_amdgcn_mfma_f32_32x32x16_bf16(pa3, PKLH(t[6], t[7]), od, 0, 0, 0);
}
__device__ __forceinline__ void pv_d0(f32x16* o, int vb, bf16x8 pa0, bf16x8 pa1, bf16x8 pa2, bf16x8 pa3) {
  s16x4 ta[8], tb[8];
  pv_issue<0>(ta, vb);
  pv_issue<1>(tb, vb); asm volatile("s_waitcnt lgkmcnt(8)" ::: "memory"); SBAR(); pv_mma(o[0], ta, pa0, pa1, pa2, pa3);
  pv_issue<2>(ta, vb); asm volatile("s_waitcnt lgkmcnt(8)" ::: "memory"); SBAR(); pv_mma(o[1], tb, pa0, pa1, pa2, pa3);
  pv_issue<3>(tb, vb); asm volatile("s_waitcnt lgkmcnt(8)" ::: "memory"); SBAR(); pv_mma(o[2], ta, pa0, pa1, pa2, pa3);
  asm volatile("s_waitcnt lgkmcnt(0)" ::: "memory"); SBAR(); pv_mma(o[3], tb, pa0, pa1, pa2, pa3);
}
#define PK4(P, BASE, OUT) do { unsigned a0 = cvt_pk(P[BASE + 0], P[BASE + 1]), a1 = cvt_pk(P[BASE + 2], P[BASE + 3]);   \
    unsigned b0 = cvt_pk(P[BASE + 4], P[BASE + 5]), b1 = cvt_pk(P[BASE + 6], P[BASE + 7]);                              \
    auto r0 = __builtin_amdgcn_permlane32_swap(a0, b0, false, false); auto r1 = __builtin_amdgcn_permlane32_swap(a1, b1, false, false); \
    u32x4 w = {r0[0], r1[0], r0[1], r1[1]}; OUT = *reinterpret_cast<bf16x8*>(&w); } while (0)

namespace att {
constexpr int DQK = 192, DV = 128, NW = 8, QBLK = 32, KVBLK = 64, NQD = DQK / 16;
constexpr int LDQ = 1536, LDK = 1536, LDV = 1024, LDO = 1024;
constexpr float SCALE = 0.07216878364870323f, THR = 8.f;
constexpr int SHM_V = KVBLK * DV * 2, SHM_K = KVBLK * DQK * 2;
#define KSWZ3(row, colB) ((row) * 384 + ((colB) ^ ((((row) >> 1) & 7) << 4)))
__device__ __forceinline__ void partialSM(f32x16& p0, f32x16& p1, float& m_reg, float& alpha, bool first) {
  constexpr float THR2 = THR * 1.4426950408889634f;
  float pmax = p0[0];
#pragma unroll
  for (int r = 1; r < 16; ++r) pmax = fmaxf(pmax, p0[r]);
#pragma unroll
  for (int r = 0; r < 16; ++r) pmax = fmaxf(pmax, p1[r]);
  { auto rr = __builtin_amdgcn_permlane32_swap(__float_as_uint(pmax), __float_as_uint(pmax), false, false);
    pmax = fmaxf(__uint_as_float(rr[0]), __uint_as_float(rr[1])); }
  if (__builtin_expect(!first && __all(pmax <= THR2), 1)) { alpha = 1.f; }
  else { const float d = first ? pmax : fmaxf(pmax, 0.f); alpha = __builtin_amdgcn_exp2f(-d); m_reg += d;
#pragma unroll
    for (int r = 0; r < 16; ++r) { p0[r] -= d; p1[r] -= d; } }
#pragma unroll
  for (int r = 0; r < 16; ++r) p0[r] = __builtin_amdgcn_exp2f(p0[r]);
}
__device__ __forceinline__ void finishSM(f32x16& p0, f32x16& p1, float alpha, float& l_reg, bf16x8& pa0, bf16x8& pa1, bf16x8& pa2, bf16x8& pa3) {
#pragma unroll
  for (int r = 0; r < 16; ++r) p1[r] = __builtin_amdgcn_exp2f(p1[r]);
  float ps = 0;
#pragma unroll
  for (int r = 0; r < 16; ++r) ps += p0[r];
#pragma unroll
  for (int r = 0; r < 16; ++r) ps += p1[r];
  { auto rr = __builtin_amdgcn_permlane32_swap(__float_as_uint(ps), __float_as_uint(ps), false, false);
    ps = __uint_as_float(rr[0]) + __uint_as_float(rr[1]); }
  l_reg = l_reg * alpha + ps;
  PK4(p0, 0, pa0); PK4(p0, 8, pa1); PK4(p1, 0, pa2); PK4(p1, 8, pa3);
}
__device__ __forceinline__ void qkt(f32x16& p0, f32x16& p1, const char* Ks, const bf16x8* qr, const char* qrl, int qsw, int r32, int hi, float init) {
#pragma unroll
  for (int r = 0; r < 16; ++r) { p0[r] = init; p1[r] = init; }
#pragma unroll
  for (int d0 = 0; d0 < 8; ++d0) { int cb = (d0 * 16 + hi * 8) * 2;
    bf16x8 b0 = *reinterpret_cast<const bf16x8*>(Ks + KSWZ3(r32, cb));
    bf16x8 b1 = *reinterpret_cast<const bf16x8*>(Ks + KSWZ3(32 + r32, cb));
    p0 = __builtin_amdgcn_mfma_f32_32x32x16_bf16(b0, qr[d0], p0, 0, 0, 0);
    p1 = __builtin_amdgcn_mfma_f32_32x32x16_bf16(b1, qr[d0], p1, 0, 0, 0); }
#pragma unroll
  for (int d0 = 0; d0 < 4; ++d0) { int cb = ((8 + d0) * 16 + hi * 8) * 2;
    bf16x8 q = *reinterpret_cast<const bf16x8*>(qrl + (((d0 * 2 + hi) ^ qsw) << 4));
    bf16x8 b0 = *reinterpret_cast<const bf16x8*>(Ks + KSWZ3(r32, cb));
    bf16x8 b1 = *reinterpret_cast<const bf16x8*>(Ks + KSWZ3(32 + r32, cb));
    p0 = __builtin_amdgcn_mfma_f32_32x32x16_bf16(b0, q, p0, 0, 0, 0);
    p1 = __builtin_amdgcn_mfma_f32_32x32x16_bf16(b1, q, p1, 0, 0, 0); }
}
__device__ __forceinline__ void attn_unit(const bf16_t* __restrict__ Qb, const bf16_t* __restrict__ Kh, const bf16_t* __restrict__ Vh, bf16_t* __restrict__ Ob, int seq, char* lds, LAS unsigned char* ldsl) {
  int tid_ = threadIdx.x; asm volatile("" : "+v"(tid_));
  const int tid = tid_, wid = __builtin_amdgcn_readfirstlane(tid >> 6), lane = tid & 63, r32 = lane & 31, hi = lane >> 5;
  constexpr int OFF_K = 3 * SHM_V, OFF_WS = 3 * SHM_V + 3 * SHM_K;
  char* V_lds = lds; char* K_lds = lds + OFF_K;
  float* ws = (float*)(lds + OFF_WS) + wid * 64; float* li_l = ws; float* al_l = ws + 32;
  float m_reg = 0.f, l_reg = 0; f32x16 o[4] = {}; bf16x8 qr[8];
  const bf16_t* Qw = Qb + (long)(wid * QBLK + r32) * LDQ + hi * 8;
#pragma unroll
  for (int d0 = 0; d0 < 8; ++d0) qr[d0] = *reinterpret_cast<const bf16x8*>(Qw + d0 * 16);
  char* qrl = lds + OFF_WS + 2048 + wid * 4096 + r32 * 128;
  const int qsw = (r32 >> 1) & 7;
#pragma unroll
  for (int d0 = 0; d0 < 4; ++d0) *(bf16x8*)(qrl + (((d0 * 2 + hi) ^ qsw) << 4)) = *reinterpret_cast<const bf16x8*>(Qw + 128 + d0 * 16);
  int kof[3], vof[2];
#pragma unroll
  for (int i = 0; i < 3; ++i) { const int L = (wid * 3 + i) * 1024 + lane * 16, row = L / 384, x = L - row * 384, cb = x ^ (((row >> 1) & 7) << 4); kof[i] = row * LDK + (cb >> 1); }
#pragma unroll
  for (int i = 0; i < 2; ++i) { const int L = (wid * 2 + i) * 1024 + lane * 16, sub = L >> 9, w = L & 511, kk = (sub >> 2) * 8 + (w >> 6), c = (sub & 3) * 32 + ((w & 63) >> 1);
    const int k = (kk & ~0xC) | ((kk & 4) << 1) | ((kk & 8) >> 1); vof[i] = k * LDV + c; }
  const int vb0 = (int)(uintptr_t)V_lds + v_rd_base(lane);
#define KVDMA(t, slot) do { const bf16_t* kb_ = Kh + (long)(t) * (KVBLK * LDK); const bf16_t* vb_ = Vh + (long)(t) * (KVBLK * LDV); \
    _Pragma("unroll") for (int i_ = 0; i_ < 3; ++i_) __builtin_amdgcn_global_load_lds((const unsigned*)(kb_ + kof[i_]), (LAS unsigned*)(ldsl + OFF_K + (slot) * SHM_K + (wid * 3 + i_) * 1024), 16, 0, 0); \
    _Pragma("unroll") for (int i_ = 0; i_ < 2; ++i_) __builtin_amdgcn_global_load_lds((const unsigned*)(vb_ + vof[i_]), (LAS unsigned*)(ldsl + (slot) * SHM_V + (wid * 2 + i_) * 1024), 16, 0, 0); } while (0)
#define TILE_SYNC() do { asm volatile("s_waitcnt vmcnt(0)" ::: "memory"); __syncthreads(); } while (0)
#define RESC(a) do { if (__any((a) < 1.f)) { if (hi == 0) al_l[r32] = (a); asm volatile("s_waitcnt lgkmcnt(0)" ::: "memory"); \
    _Pragma("unroll") for (int d = 0; d < 4; ++d) _Pragma("unroll") for (int r = 0; r < 16; ++r) o[d][r] *= al_l[crow(r, hi)]; } } while (0)
  f32x16 pA0, pA1, pB0, pB1; float alA, alB; bf16x8 pa0, pa1, pa2, pa3; const int NT = seq / KVBLK;
  KVDMA(0, 0); KVDMA(1, 1); TILE_SYNC();
  qkt(pA0, pA1, K_lds, qr, qrl, qsw, r32, hi, 0.f); partialSM(pA0, pA1, m_reg, alA, true);
  int sK = 1, sV = 0, sN = 2;
#define NEXT3(x) ((x) == 2 ? 0 : (x) + 1)
  for (int j = 1; j + 1 < NT; j += 2) {
    KVDMA(j + 1, sN);
    SBAR(); qkt(pB0, pB1, K_lds + sK * SHM_K, qr, qrl, qsw, r32, hi, -m_reg);
    finishSM(pA0, pA1, alA, l_reg, pa0, pa1, pa2, pa3); SBAR();
    pv_d0(o, vb0 + sV * SHM_V, pa0, pa1, pa2, pa3); partialSM(pB0, pB1, m_reg, alB, false);
    RESC(alB); TILE_SYNC();
    sV = sK; sK = sN; sN = NEXT3(sN);
    if (j + 2 < NT) KVDMA(j + 2, sN);
    SBAR(); qkt(pA0, pA1, K_lds + sK * SHM_K, qr, qrl, qsw, r32, hi, -m_reg);
    finishSM(pB0, pB1, alB, l_reg, pa0, pa1, pa2, pa3); SBAR();
    pv_d0(o, vb0 + sV * SHM_V, pa0, pa1, pa2, pa3); partialSM(pA0, pA1, m_reg, alA, false);
    RESC(alA); TILE_SYNC();
    sV = sK; sK = sN; sN = NEXT3(sN);
  }
  SBAR(); qkt(pB0, pB1, K_lds + sK * SHM_K, qr, qrl, qsw, r32, hi, -m_reg);
  finishSM(pA0, pA1, alA, l_reg, pa0, pa1, pa2, pa3); SBAR();
  pv_d0(o, vb0 + sV * SHM_V, pa0, pa1, pa2, pa3); partialSM(pB0, pB1, m_reg, alB, false);
  RESC(alB);
  finishSM(pB0, pB1, alB, l_reg, pa0, pa1, pa2, pa3); SBAR();
  pv_d0(o, vb0 + sK * SHM_V, pa0, pa1, pa2, pa3);
  if (hi == 0) li_l[r32] = l_reg; asm volatile("s_waitcnt lgkmcnt(0)" ::: "memory");
  float rli[16];
#pragma unroll
  for (int r = 0; r < 16; ++r) rli[r] = __builtin_amdgcn_rcpf(li_l[crow(r, hi)]);
  bf16_t* Ow = Ob + (long)(wid * QBLK) * LDO;
#pragma unroll
  for (int r = 0; r < 16; ++r) { int orow = crow(r, hi);
#pragma unroll
    for (int d0 = 0; d0 < 4; ++d0) Ow[(long)orow * LDO + d0 * 32 + r32] = (bf16_t)(cvt_pk(o[d0][r] * rli[r], 0.f) & 0xffffu); }
  __syncthreads();
#undef KVDMA
#undef TILE_SYNC
#undef RESC
#undef NEXT3
}
}

#define KSWZ(row, colB) ((row) * 256 + ((colB) ^ ((((row) & 7) << 4) | ((((row) >> 3) & 1) << 7))))
__device__ __forceinline__ bf16x8 scale8(bf16x8 x, float s) {
  u32x4 w = *reinterpret_cast<u32x4*>(&x);
  u32x4 o = {cvt_pk(bflo(w.x) * s, bfhi(w.x) * s), cvt_pk(bflo(w.y) * s, bfhi(w.y) * s), cvt_pk(bflo(w.z) * s, bfhi(w.z) * s), cvt_pk(bflo(w.w) * s, bfhi(w.w) * s)};
  return *reinterpret_cast<bf16x8*>(&o);
}
__device__ __forceinline__ void stage_v_chunk(const bf16_t* Vg, char* lds, int tid) {
#pragma unroll
  for (int i = 0; i < 8; ++i) { const int p = tid + 512 * i, row = p >> 5, col = (p & 31) * 8;
    const bf16x8 v = *reinterpret_cast<const bf16x8*>(Vg + (size_t)row * 1024 + col);
    *(bf16x8*)(lds + ((row >> 6) * 2 + (col >> 7)) * 16384 + v_st(row & 63, col & 127)) = v; }
}
template <int OFF> __device__ __forceinline__ bf16x8 tr_frag(int base) { const s16x4 l = tr_read<OFF>(base), h = tr_read<OFF + 2048>(base); asm volatile("s_waitcnt lgkmcnt(0)" ::: "memory"); return PKLH(l, h); }

__device__ __forceinline__ void ret_kv_item(const Bufs& b, int item, float lgf2, float lgb2, char* lds) {
  int tid_ = threadIdx.x; asm volatile("" : "+v"(tid_));
  const int tid = tid_, wid = tid >> 6, lane = tid & 63, r32 = lane & 31, hi = lane >> 5;
  const int ci = item >> 2, h = item & 3; const size_t tok0 = (size_t)ci * 128;
  const bf16_t* Kg = b.RK + tok0 * 512 + h * 128; const bf16_t* Vg = b.RV + tok0 * 1024 + h * 256;
  stage_v_chunk(Vg, lds, tid);
#pragma unroll
  for (int i = 0; i < 4; ++i) { const int p = tid + 512 * i, row = p >> 4, col = (p & 15) * 8;
    const bf16x8 k = *reinterpret_cast<const bf16x8*>(Kg + (size_t)row * 512 + col);
    const float sf = __builtin_amdgcn_exp2f(lgf2 * (float)(127 - row)), sb = __builtin_amdgcn_exp2f(lgb2 * (float)row);
    const int off = (row >> 6) * 16384 + v_st(row & 63, col);
    *(bf16x8*)(lds + 65536 + off) = scale8(k, sf); *(bf16x8*)(lds + 98304 + off) = scale8(k, sb); }
  __syncthreads();
  const int rb = v_rd_base(lane), lb = (int)(uintptr_t)lds;
  const int vbase = lb + (wid >> 2) * 16384 + rb + (wid & 3) * 512;
#define R1_STEP(T, KS, KOFF) do { const bf16x8 a = tr_frag<v_rd_off(0, KS, 0)>(vbase + (T) * 32768); \
    { const int kf = lb + (KOFF) + (T) * 16384 + rb; \
      const bf16x8 f0 = tr_frag<v_rd_off(0, KS, 0)>(kf), f1 = tr_frag<v_rd_off(1, KS, 0)>(kf), f2 = tr_frag<v_rd_off(2, KS, 0)>(kf), f3 = tr_frag<v_rd_off(3, KS, 0)>(kf); \
      aF[0] = __builtin_amdgcn_mfma_f32_32x32x16_bf16(a, f0, aF[0], 0, 0, 0); aF[1] = __builtin_amdgcn_mfma_f32_32x32x16_bf16(a, f1, aF[1], 0, 0, 0); \
      aF[2] = __builtin_amdgcn_mfma_f32_32x32x16_bf16(a, f2, aF[2], 0, 0, 0); aF[3] = __builtin_amdgcn_mfma_f32_32x32x16_bf16(a, f3, aF[3], 0, 0, 0); } SBAR(); } while (0)
#pragma unroll
  for (int dir = 0; dir < 2; ++dir) {
    f32x16 aF[4] = {};
    if (dir == 0) { R1_STEP(0, 0, 65536); R1_STEP(0, 1, 65536); R1_STEP(0, 2, 65536); R1_STEP(0, 3, 65536); R1_STEP(1, 0, 65536); R1_STEP(1, 1, 65536); R1_STEP(1, 2, 65536); R1_STEP(1, 3, 65536); }
    else { R1_STEP(0, 0, 98304); R1_STEP(0, 1, 98304); R1_STEP(0, 2, 98304); R1_STEP(0, 3, 98304); R1_STEP(1, 0, 98304); R1_STEP(1, 1, 98304); R1_STEP(1, 2, 98304); R1_STEP(1, 3, 98304); }
    bf16_t* od = b.KV + (size_t)item * 65536 + dir * 32768;
#pragma unroll
    for (int n0 = 0; n0 < 4; ++n0)
#pragma unroll
      for (int r = 0; r < 16; ++r) od[(32 * wid + crow(r, hi)) * 128 + 32 * n0 + r32] = (bf16_t)(cvt_pk_s(aF[n0][r], 0.f) & 0xffffu);
    SBAR();
  }
#undef R1_STEP
  __syncthreads();
}

__device__ __forceinline__ float lg2_of(const float* dec, int h);
__device__ __forceinline__ void ret_scan(const Bufs& b, int nseq, int NC, const float* dec_f, const float* dec_b, int gtid, int gthreads) {
  const int nvec = nseq * 32768;
  for (int v = gtid; v < nvec; v += gthreads) {
    const int e8 = v & 4095, dir = (v >> 12) & 1, h = (v >> 13) & 3, s = v >> 15;
    const float decay = __builtin_amdgcn_exp2f(lg2_of(dir ? dec_b : dec_f, h) * 128.f);
    float st[8];
#pragma unroll
    for (int e = 0; e < 8; ++e) st[e] = 0.f;
    for (int step = 0; step < NC; step += 4) {
      u32x4 kv[4]; bf16_t* ptr[4];
#pragma unroll
      for (int q = 0; q < 4; ++q) { const int c = dir ? NC - 1 - (step + q) : step + q; ptr[q] = b.KV + ((size_t)(((s * NC + c) * 4 + h) * 2 + dir)) * 32768 + e8 * 8; kv[q] = *(const u32x4*)ptr[q]; }
#pragma unroll
      for (int q = 0; q < 4; ++q) {
        u32x4 o = {cvt_pk(st[0], st[1]), cvt_pk(st[2], st[3]), cvt_pk(st[4], st[5]), cvt_pk(st[6], st[7])}; *(u32x4*)ptr[q] = o;
        st[0] = st[0] * decay + bflo(kv[q].x); st[1] = st[1] * decay + bfhi(kv[q].x); st[2] = st[2] * decay + bflo(kv[q].y); st[3] = st[3] * decay + bfhi(kv[q].y);
        st[4] = st[4] * decay + bflo(kv[q].z); st[5] = st[5] * decay + bfhi(kv[q].z); st[6] = st[6] * decay + bflo(kv[q].w); st[7] = st[7] * decay + bfhi(kv[q].w); }
    }
  }
}

__device__ __forceinline__ void qkt128(f32x16& p0, f32x16& p1, const char* Ks, const bf16x8* qr, int r32, int hi) {
  p0 = f32x16{}; p1 = f32x16{};
#pragma unroll
  for (int d0 = 0; d0 < 8; ++d0) { int cb = (d0 * 16 + hi * 8) * 2;
    bf16x8 b0 = *reinterpret_cast<const bf16x8*>(Ks + KSWZ(r32, cb));
    bf16x8 b1 = *reinterpret_cast<const bf16x8*>(Ks + KSWZ(32 + r32, cb));
    p0 = __builtin_amdgcn_mfma_f32_32x32x16_bf16(b0, qr[d0], p0, 0, 0, 0);
    p1 = __builtin_amdgcn_mfma_f32_32x32x16_bf16(b1, qr[d0], p1, 0, 0, 0); }
}
__device__ __forceinline__ void ret_out_item(const Bufs& b, int item, float lgf2, float lgb2, const float* gn_g, char* lds) {
  int tid_ = threadIdx.x; asm volatile("" : "+v"(tid_));
  const int tid = tid_, wid = tid >> 6, lane = tid & 63, r32 = lane & 31, hi = lane >> 5, wr = wid & 3, wc = wid >> 2;
  const int ci = item >> 2, h = item & 3; const size_t tok0 = (size_t)ci * 128;
  const bf16_t* Qg = b.RQ + tok0 * 512 + h * 128; const bf16_t* Kg = b.RK + tok0 * 512 + h * 128; const bf16_t* Vg = b.RV + tok0 * 1024 + h * 256;
  const bf16_t* Sf = b.KV + (size_t)item * 65536; const bf16_t* Sb = Sf + 32768;
  char* K_lds = lds; char* V_lds = lds + 32768;
#pragma unroll
  for (int i = 0; i < 4; ++i) { const int p = tid + 512 * i, row = p >> 4, col = (p & 15) * 8;
    *(bf16x8*)(K_lds + KSWZ(row, col * 2)) = *reinterpret_cast<const bf16x8*>(Kg + (size_t)row * 512 + col); }
  stage_v_chunk(Vg, V_lds, tid);
  bf16x8 qr[8];
  { const bf16_t* Qw = Qg + (size_t)(wr * 32 + r32) * 512 + hi * 8;
#pragma unroll
    for (int d0 = 0; d0 < 8; ++d0) qr[d0] = *reinterpret_cast<const bf16x8*>(Qw + d0 * 16); }
  __syncthreads();
  f32x16 o[4] = {};
  const int irow = wr * 32 + r32;
#pragma unroll
  for (int t = 0; t < 2; ++t) {
    f32x16 p0, p1; qkt128(p0, p1, K_lds + t * 16384, qr, r32, hi);
#pragma unroll
    for (int r = 0; r < 16; ++r) { const int j0 = 64 * t + crow(r, hi), d0_ = irow - j0, d1_ = d0_ - 32;
      p0[r] *= __builtin_amdgcn_exp2f(d0_ >= 0 ? lgf2 * (float)d0_ : lgb2 * (float)(-d0_));
      p1[r] *= __builtin_amdgcn_exp2f(d1_ >= 0 ? lgf2 * (float)d1_ : lgb2 * (float)(-d1_)); }
    bf16x8 pa0, pa1, pa2, pa3; PK4(p0, 0, pa0); PK4(p0, 8, pa1); PK4(p1, 0, pa2); PK4(p1, 8, pa3);
    pv_d0(o, (int)(uintptr_t)V_lds + (t * 2 + wc) * 16384 + v_rd_base(lane), pa0, pa1, pa2, pa3);
    SBAR();
  }
  bf16x8 sfv[8], sbv[8];
#pragma unroll
  for (int i = 0; i < 8; ++i) { const int p = tid + 512 * i, row = p >> 4, col = (p & 15) * 8;
    sfv[i] = *reinterpret_cast<const bf16x8*>(Sf + (size_t)row * 128 + col); sbv[i] = *reinterpret_cast<const bf16x8*>(Sb + (size_t)row * 128 + col); }
  __syncthreads();
#pragma unroll
  for (int i = 0; i < 8; ++i) { const int p = tid + 512 * i, row = p >> 4, col = (p & 15) * 8;
    *(bf16x8*)(lds + KSWZ(row, col * 2)) = sfv[i]; *(bf16x8*)(lds + 65536 + KSWZ(row, col * 2)) = sbv[i]; }
  const float qdf = __builtin_amdgcn_exp2f(lgf2 * (float)(irow + 1)), qdb = __builtin_amdgcn_exp2f(lgb2 * (float)(128 - irow));
  __syncthreads();
#pragma unroll
  for (int s = 0; s < 8; ++s) { const bf16x8 af = scale8(qr[s], qdf), ab = scale8(qr[s], qdb); const int cb = (s * 16 + hi * 8) * 2;
#pragma unroll
    for (int d = 0; d < 4; ++d) { const int srow = 128 * wc + 32 * d + r32;
      const bf16x8 bf = *reinterpret_cast<const bf16x8*>(lds + KSWZ(srow, cb)), bb = *reinterpret_cast<const bf16x8*>(lds + 65536 + KSWZ(srow, cb));
      o[d] = __builtin_amdgcn_mfma_f32_32x32x16_bf16(af, bf, o[d], 0, 0, 0);
      o[d] = __builtin_amdgcn_mfma_f32_32x32x16_bf16(ab, bb, o[d], 0, 0, 0); }
    SBAR(); }
  const int nrow = tid >> 2, nq = tid & 3; const size_t gofs = (tok0 + nrow) * 1024 + h * 256 + nq * 8; u32x4 rgv[8];
#pragma unroll
  for (int k = 0; k < 8; ++k) rgv[k] = *(const u32x4*)(b.RG + gofs + 32 * k);
  __syncthreads();
  float* ol = (float*)lds;
#pragma unroll
  for (int d = 0; d < 4; ++d)
#pragma unroll
    for (int r = 0; r < 16; ++r) ol[(wr * 32 + crow(r, hi)) * 260 + wc * 128 + d * 32 + r32] = o[d][r];
  __syncthreads();
  { const int row = nrow, q = nq; const float* rp = ol + row * 260 + q * 8;
    f32x4 x[16]; float s = 0.f;
#pragma unroll
    for (int k = 0; k < 8; ++k) { x[2 * k] = *(const f32x4*)(rp + 32 * k); x[2 * k + 1] = *(const f32x4*)(rp + 32 * k + 4); s += (x[2 * k][0] + x[2 * k][1]) + (x[2 * k][2] + x[2 * k][3]) + (x[2 * k + 1][0] + x[2 * k + 1][1]) + (x[2 * k + 1][2] + x[2 * k + 1][3]); }
    s += __shfl_xor(s, 1); s += __shfl_xor(s, 2); const float mu = s * (1.f / 256.f); float v = 0.f;
#pragma unroll
    for (int k = 0; k < 16; ++k) { x[k] = x[k] - mu; v += dot4(x[k]); }
    v += __shfl_xor(v, 1); v += __shfl_xor(v, 2); const float rstd = rsqrtf(v * (1.f / 256.f) + EPS);
    const float* gp = gn_g + h * 256 + q * 8;
#pragma unroll
    for (int k = 0; k < 8; ++k) { const u32x4 rw = rgv[k]; const f32x4 ga = {bflo(rw.x), bfhi(rw.x), bflo(rw.y), bfhi(rw.y)}, gb = {bflo(rw.z), bfhi(rw.z), bflo(rw.w), bfhi(rw.w)}; const f32x4 w0 = *(const f32x4*)(gp + 32 * k), w1 = *(const f32x4*)(gp + 32 * k + 4);
      st8(b.URET + gofs + 32 * k, x[2 * k] * rstd * w0 * ga, x[2 * k + 1] * rstd * w1 * gb); } }
  __syncthreads();
}

__device__ __forceinline__ int src_col(int mat, int n) {
  if (mat == 0) {
    if (n < 1024) { const int base = n & ~127, hc = n & 127; return base + ((hc & 1) ? (hc >> 1) + 64 : (hc >> 1)); }
    if (n < 3072) return n;
    if (n < 4096) return 3776 + (n - 3072);
    if (n < 5120) return 4800 + (n - 4096);
    if (n < 5504) return 3072 + (n - 5120);
    if (n < 5568) { const int kc = n - 5504; return 3712 + ((kc & 1) ? (kc >> 1) + 32 : (kc >> 1)); }
    if (n < 5632) return -1;
    return 3456 + (n - 5632);
  }
  if (mat == 1) { const int head = n >> 8, hc = n & 255; if (hc < 128) return head * 192 + hc; if (hc < 192) { const int kc = hc - 128; return head * 192 + 128 + ((kc & 1) ? (kc >> 1) + 32 : (kc >> 1)); } return -1; }
  return n;
}
__device__ __forceinline__ void prep_tile(const float* W, int K, int Nsrc, const float* gain, bf16_t* Bt, int mat, int n0, int k0, float* scr, int tid) {
  const int tx = tid & 63, ty = tid >> 6; const int src = src_col(mat, n0 + tx);
#pragma unroll
  for (int kk = ty; kk < 64; kk += 8) { float v = 0.f; if (src >= 0) { v = W[(size_t)(k0 + kk) * Nsrc + src]; if (gain) v *= gain[k0 + kk]; } scr[kk * 65 + tx] = v; }
  __syncthreads();
  { const int n = tid >> 3, kq = (tid & 7) * 8; const float* s = scr + kq * 65 + n;
    u32x4 o = {cvt_pk(s[0], s[65]), cvt_pk(s[130], s[195]), cvt_pk(s[260], s[325]), cvt_pk(s[390], s[455])};
    *(u32x4*)(Bt + (size_t)(n0 + n) * K + k0 + kq) = o; }
  __syncthreads();
}
__device__ __forceinline__ void h1_rows(const Bufs& b, const float* gmix, int CH, int gw, int ngw_, int lane_) {
  int lane = lane_; asm volatile("" : "+v"(lane)); int ngw = ngw_; asm volatile("" : "+s"(ngw));
  for (int r = gw * 4; r < CH; r += ngw * 4) {
    f32x4 v[4][4]; float s[4];
#pragma unroll
    for (int q = 0; q < 4; ++q) { const f32x4* xq = (const f32x4*)xrow(b, b.g0 + r + q) + lane;
#pragma unroll
      for (int j = 0; j < 4; ++j) v[q][j] = xq[64 * j]; }
#pragma unroll
    for (int q = 0; q < 4; ++q) { s[q] = 0.f;
#pragma unroll
      for (int j = 0; j < 4; ++j) s[q] += dot4(v[q][j]); }
#pragma unroll
    for (int o = 1; o < 64; o <<= 1) {
#pragma unroll
      for (int q = 0; q < 4; ++q) s[q] += __shfl_xor(s[q], o); }
#pragma unroll
    for (int q = 0; q < 4; ++q) { const float rs = rsqrtf(s[q] * (1.f / 1024.f) + EPS); u32x2* oq = (u32x2*)(b.H1O + (size_t)(r + q) * 1024) + lane;
#pragma unroll
      for (int j = 0; j < 4; ++j) { const f32x4 g = ((const f32x4*)gmix)[lane + 64 * j]; const f32x4 y = v[q][j] * rs * g; u32x2 w = {cvt_pk(y[0], y[1]), cvt_pk(y[2], y[3])}; oq[64 * j] = w; } } }
}
__device__ __forceinline__ void conv_gate(const Bufs& b, const float* cw, const float* cbias, int CH, int bid, int nb, int tid) {
  if (tid >= 352) return;
  const int c = tid * 8;
  float w[2][3][8], bs[2][8];
#pragma unroll
  for (int hf = 0; hf < 2; ++hf) {
#pragma unroll
    for (int k = 0; k < 3; ++k) { const f32x4 a = *(const f32x4*)(cw + (size_t)k * N_UP + hf * DFF + c), d = *(const f32x4*)(cw + (size_t)k * N_UP + hf * DFF + c + 4);
#pragma unroll
      for (int e = 0; e < 4; ++e) { w[hf][k][e] = a[e]; w[hf][k][4 + e] = d[e]; } }
    const f32x4 a = *(const f32x4*)(cbias + hf * DFF + c), d = *(const f32x4*)(cbias + hf * DFF + c + 4);
#pragma unroll
    for (int e = 0; e < 4; ++e) { bs[hf][e] = a[e]; bs[hf][4 + e] = d[e]; } }
  for (int strip = bid; strip < CH / 8; strip += nb) {
    const int r0 = strip * 8; const int pos0 = (b.g0 + r0) & b.slm;
    u32x4 raw[2][10];
    const bool hp = pos0 > 0, hn = (pos0 + 8) <= b.slm;
#pragma unroll
    for (int hf = 0; hf < 2; ++hf) {
      const bf16_t* base = b.UR + (size_t)r0 * N_UP + hf * DFF + c;
      raw[hf][0] = hp ? *(const u32x4*)(base - N_UP) : (u32x4){0u, 0u, 0u, 0u};
#pragma unroll
      for (int i = 0; i < 8; ++i) raw[hf][1 + i] = *(const u32x4*)(base + (size_t)i * N_UP);
      raw[hf][9] = hn ? *(const u32x4*)(base + (size_t)8 * N_UP) : (u32x4){0u, 0u, 0u, 0u};
    }
#pragma unroll
    for (int i = 0; i < 8; ++i) {
      float ua[8], ub[8];
#pragma unroll
      for (int e = 0; e < 8; ++e) { ua[e] = bs[0][e]; ub[e] = bs[1][e]; }
#pragma unroll
      for (int k = 0; k < 3; ++k) { const u32x4 xa = raw[0][i + k], xb = raw[1][i + k];
        const float fa[8] = {bflo(xa.x), bfhi(xa.x), bflo(xa.y), bfhi(xa.y), bflo(xa.z), bfhi(xa.z), bflo(xa.w), bfhi(xa.w)};
        const float fb[8] = {bflo(xb.x), bfhi(xb.x), bflo(xb.y), bfhi(xb.y), bflo(xb.z), bfhi(xb.z), bflo(xb.w), bfhi(xb.w)};
#pragma unroll
        for (int e = 0; e < 8; ++e) { ua[e] += fa[e] * w[0][k][e]; ub[e] += fb[e] * w[1][k][e]; } }
      f32x4 y0, y1;
#pragma unroll
      for (int e = 0; e < 4; ++e) { y0[e] = ua[e] * sigm(ua[e]) * ub[e]; y1[e] = ua[4 + e] * sigm(ua[4 + e]) * ub[4 + e]; }
      st8(b.G + (size_t)(r0 + i) * DFF + c, y0, y1);
    }
  }
}


#define XB_TMO      128
#define XB_XCNT(j)  (256  + 64 * (j))
#define XB_XSUB(j)  (1280 + 64 * (j))
#define XB_XGEN(j)  (2304 + 64 * (j))
#define XB_TOP      3328
#define XB_TOPGEN   3392
#define XCD_BAR_WORDS 3456
#define XB_SPIN_CAP (1u << 18)
__device__ __forceinline__ unsigned xb_ld(unsigned* p)              { return __hip_atomic_load(p, __ATOMIC_RELAXED, __HIP_MEMORY_SCOPE_AGENT); }
__device__ __forceinline__ unsigned xb_add(unsigned* p, unsigned v) { return __hip_atomic_fetch_add(p, v, __ATOMIC_RELAXED, __HIP_MEMORY_SCOPE_AGENT); }
__device__ __forceinline__ unsigned xb_xcc_id() { return (unsigned)__builtin_amdgcn_s_getreg((3 << 11) | 20) & 0xFu; }
#define XB_SPIN(cond, bar) do { unsigned _sp = 0; while (cond) { __builtin_amdgcn_s_sleep(1); \
    if ((++_sp & 255u) == 0u) { if (xb_ld(&(bar)[XB_TMO])) break; if (_sp > XB_SPIN_CAP) { atomicAdd(&(bar)[XB_TMO], 1u); break; } } } } while (0)
struct XcdBarrier { unsigned* bar; unsigned x; volatile LAS unsigned* st; };
__device__ __forceinline__ XcdBarrier xcd_barrier_post(unsigned* bar, volatile LAS unsigned* st) {
  XcdBarrier b; b.bar = bar; b.x = xb_xcc_id(); b.st = st;
  if (threadIdx.x == 0) (void)xb_add(&bar[XB_XCNT(b.x)], 1u);
  return b;
}
__device__ __forceinline__ void xcd_barrier_complete(unsigned* bar, unsigned x, unsigned& nloc, unsigned& nx) {
  const unsigned G = gridDim.x * gridDim.y * gridDim.z;
  unsigned sum, cnt, mine, sp = 0u;
  for (;;) {
    sum = 0u; cnt = 0u; mine = 0u;
#pragma unroll
    for (unsigned j = 0; j < 16; ++j) { const unsigned c = xb_ld(&bar[XB_XCNT(j)]); sum += c; cnt += (c > 0u) ? 1u : 0u; mine = (j == x) ? c : mine; }
    if (sum == G) break;
    __builtin_amdgcn_s_sleep(1);
    if ((++sp & 255u) == 0u) { if (xb_ld(&bar[XB_TMO])) break; if (sp > XB_SPIN_CAP) { atomicAdd(&bar[XB_TMO], 1u); break; } }
  }
  nloc = mine > 0u ? mine : 1u; nx = cnt > 0u ? cnt : 1u;
}
__device__ __forceinline__ void xcd_barrier(const XcdBarrier& b) {
  asm volatile("s_waitcnt vmcnt(0)" ::: "memory");
  __syncthreads();
  if (threadIdx.x == 0) {
    unsigned* bar = b.bar;
    __builtin_amdgcn_s_waitcnt(0);
    unsigned nloc = b.st[0], nx = b.st[1];
    if (nloc == 0u) { xcd_barrier_complete(bar, b.x, nloc, nx); b.st[0] = nloc; b.st[1] = nx; }
    const unsigned old = xb_add(&bar[XB_XSUB(b.x)], 1u);
    const unsigned gen = old / nloc;
    if (old + 1u == (gen + 1u) * nloc) {
      __builtin_amdgcn_fence(__ATOMIC_RELEASE, "agent");
      asm volatile("s_waitcnt vmcnt(0)" ::: "memory");
      const unsigned og = xb_add(&bar[XB_TOP], 1u);
      const unsigned tg = og / nx;
      if (og + 1u == (tg + 1u) * nx) xb_add(&bar[XB_TOPGEN], 1u);
      else XB_SPIN(xb_ld(&bar[XB_TOPGEN]) == tg, bar);
      __builtin_amdgcn_fence(__ATOMIC_ACQUIRE, "agent");
      xb_add(&bar[XB_XGEN(b.x)], 1u);
      asm volatile("s_waitcnt vmcnt(0)" ::: "memory");
    } else {
      XB_SPIN(xb_ld(&bar[XB_XGEN(b.x)]) == gen, bar);
      __builtin_amdgcn_fence(__ATOMIC_ACQUIRE, "agent");
      asm volatile("s_waitcnt vmcnt(0)" ::: "memory");
    }
  }
  __syncthreads();
}

typedef const __attribute__((address_space(4))) Args* KArgsP;
__device__ __forceinline__ KArgsP kargs() { KArgsP p = (KArgsP)__builtin_amdgcn_kernarg_segment_ptr(); asm volatile("" : "+s"(p)); return p; }
template <int CHT> __device__ __forceinline__ Bufs make_bufs(KArgsP ap, int chunk) {
  Bufs b; unsigned char* ws = ap->ws; asm volatile("" : "+s"(ws)); unsigned char* cb = ws + WS_PERM_END; constexpr size_t CH = (size_t)CHT;
  b.H1O = (bf16_t*)(cb + PT_H1O * CH); b.RG = (bf16_t*)(cb + PT_RG * CH); b.RQ = (bf16_t*)(cb + PT_RQ * CH); b.RK = (bf16_t*)(cb + PT_RK * CH); b.RV = (bf16_t*)(cb + PT_RV * CH);
  b.GR = (bf16_t*)(cb + PT_GR * CH); b.GA = (bf16_t*)(cb + PT_GA * CH); b.CQ = (bf16_t*)(cb + PT_CQ * CH); b.CKV = (bf16_t*)(cb + PT_CKV * CH); b.KR = (bf16_t*)(cb + PT_KR * CH);
  b.Q = (bf16_t*)(cb + PT_Q * CH); b.K = (bf16_t*)(cb + PT_K * CH); b.V = (bf16_t*)(cb + PT_V * CH); b.URET = (bf16_t*)(cb + PT_URET * CH); b.KV = (bf16_t*)(cb + PT_KV * CH);
  b.UR = (bf16_t*)(cb + PT_UR * CH); b.G = (bf16_t*)(cb + PT_G * CH);
  b.rope = (const float*)(ws + WS_ROPE); float* sq = (float*)(ws + WS_SSQ); b.ssq_cq = sq; b.ssq_ckv = sq + 8 * (size_t)TT; b.ssq_kr = sq + 12 * (size_t)TT; b.ssq_x1 = sq + 14 * (size_t)TT;
  b.gqp = (const float*)(ws + WS_GP); b.gkp = b.gqp + 256;
  b.xp = ap->in[0]; b.xs = ap->in[1]; b.out = ap->out; b.g0 = chunk * CHT; b.slm = (b.g0 < NP) ? 4095 : 8191;
  return b;
}

__device__ __forceinline__ float lg2_of(const float* dec, int h) { return -log1pf(__expf(-dec[h])) * 1.4426950408889634f; }
template <int CH>
__global__ void __launch_bounds__(512, 2) fwd_kernel(Args a) {
  extern __shared__ __attribute__((aligned(16))) unsigned char lds_raw[];
  LAS unsigned char* lds = (LAS unsigned char*)lds_raw;
  char* ldsg = (char*)lds_raw;
  const int bid = blockIdx.x, G = gridDim.x;
  constexpr int nchunk = TT / CH;
  volatile LAS unsigned* bst = (volatile LAS unsigned*)(lds + LDS_BYTES - 16);
  if (threadIdx.x == 0) { bst[0] = 0u; bst[1] = 0u; }
  __syncthreads();
  XcdBarrier xbar; xbar.bar = nullptr; xbar.x = 0; xbar.st = bst;
#define PHASE_BEGIN(do_it) { for (int rs_ = 0; rs_ < DUP_SYNC; ++rs_) { XcdBarrier xb_ = xbar; xb_.bar = (unsigned*)(kargs()->ws + WS_BAR); xcd_barrier(xb_); } do_it = true; }
#define TIDS int tid = threadIdx.x; asm volatile("" : "+v"(tid)); const int lane = tid & 63, wid = tid >> 6; (void)lane; (void)wid
#define WSL unsigned char* ws = kargs()->ws; asm volatile("" : "+s"(ws))
#define WT(off) ((bf16_t*)(ws + (off)))
  bool run;
  run = true;
  if (run && PM(0)) for (int rep_ = 0; rep_ < DUP_P0; ++rep_) {
    TIDS; WSL; const int gtid = bid * 512 + tid, gthreads = G * 512;
    {
      const int T0 = 92 * 16, T1 = T0 + 32 * 6, T2 = T1 + 32 * 4, T3 = T2 + 256, T4 = T3 + 256, T5 = T4 + 256, T6 = T5 + 88 * 16, T7 = T6 + 16 * 44;
      for (int t = bid; t < T7; t += G) {
        if (t < T0) { prep_tile(kargs()->in[3], 1024, 5824, nullptr, WT(WS_WIN), 0, (t / 16) * 64, (t % 16) * 64, (float*)ldsg, tid); }
        else if (t < T1) { const int q = t - T0; prep_tile(kargs()->in[9], 384, 1536, kargs()->in[8], WT(WS_WUQ), 1, (q / 6) * 64, (q % 6) * 64, (float*)ldsg, tid); }
        else if (t < T2) { const int q = t - T1; prep_tile(kargs()->in[11], 256, 2048, kargs()->in[10], WT(WS_WUKV), 2, (q / 4) * 64, (q % 4) * 64, (float*)ldsg, tid); }
        else if (t < T3) { const int q = t - T2; prep_tile(kargs()->in[7], 1024, 1024, nullptr, WT(WS_WRO), 2, (q / 16) * 64, (q % 16) * 64, (float*)ldsg, tid); }
        else if (t < T4) { const int q = t - T3; prep_tile(kargs()->in[14], 1024, 1024, nullptr, WT(WS_WMO), 2, (q / 16) * 64, (q % 16) * 64, (float*)ldsg, tid); }
        else if (t < T5) { const int q = t - T4; prep_tile(kargs()->in[15], 1024, 1024, nullptr, WT(WS_WOUT), 2, (q / 16) * 64, (q % 16) * 64, (float*)ldsg, tid); }
        else if (t < T6) { const int q = t - T5; prep_tile(kargs()->in[17], 1024, N_UP, kargs()->in[16], WT(WS_WUP), 2, (q / 16) * 64, (q % 16) * 64, (float*)ldsg, tid); }
        else { const int q = t - T6; prep_tile(kargs()->in[20], DFF, 1024, nullptr, WT(WS_WDN), 2, (q / 44) * 64, (q % 44) * 64, (float*)ldsg, tid); }
      }
    }
    { float* rope = (float*)(ws + WS_ROPE);
      for (int i = gtid; i < 8192 * 64; i += gthreads) { const int pos = i >> 6, fi = i & 63;
        const double inv = exp2(-(double)fi * (13.287712379549449 / 64.0)); double rev = (double)pos * inv * 0.15915494309189535; rev -= floor(rev);
        const float rf = (float)rev; rope[2 * i] = __builtin_amdgcn_cosf(rf); rope[2 * i + 1] = __builtin_amdgcn_sinf(rf); } }
    if (bid == 0) { unsigned* bw = (unsigned*)(ws + WS_BAR); for (int i = tid; i < 4096; i += 512) bw[i] = 0u; }
    if (bid == 0 && tid < 256) { float* gp = (float*)(ws + WS_GP); const int c = tid; const float *g_qn = kargs()->in[12], *g_kn = kargs()->in[13];
      float q, k; if (c < 128) { q = g_qn[c]; k = g_kn[c]; } else if (c < 192) { const int kc = c - 128, d = (kc & 1) ? (kc >> 1) + 32 : (kc >> 1); q = g_qn[128 + d]; k = g_kn[128 + d]; } else { q = 0.f; k = 0.f; }
      gp[c] = q; gp[256 + c] = k; }
    { const Bufs b = make_bufs<CH>(kargs(), 0); h1_rows(b, kargs()->in[2], CH, bid * 8 + wid, G * 8, lane); }
  }
  cg::this_grid().sync();
  { XcdBarrier p_ = xcd_barrier_post((unsigned*)(kargs()->ws + WS_BAR), bst); xbar.x = p_.x; }
  for (int chunk = 0; chunk < nchunk; ++chunk) {
    const int SL = (chunk * CH < NP) ? 4096 : 8192, nseq = CH / SL, NC = SL / 128;
#define MKB const Bufs b = make_bufs<CH>(kargs(), chunk)
    PHASE_BEGIN(run);
    if (run && PM(1)) for (int rep_ = 0; rep_ < DUP_P1; ++rep_) { MKB; WSL; pg8::Gemm g{b.H1O, WT(WS_WIN), CH, N_IN, 1024, 1024}; pg8::StaticOrder S; S.init(CH, N_IN, G, bid); EpiIn E{b, rep_ == 0}; pg8::gemm_phase(lds, g, S, E); }
    PHASE_BEGIN(run);
    if (run && PM(2)) {
      for (int rep_ = 0; rep_ < DUP_P2G; ++rep_) {
      if (PM(10)) { MKB; WSL; pg8::Gemm g{b.CQ, WT(WS_WUQ), CH, 2048, 384, 384}; pg8::StaticOrder S; S.init(CH, 2048, G, bid); EpiQ E{b}; pg8::gemm_phase(lds, g, S, E); }
      if (PM(11)) { MKB; WSL; pg8::Gemm g{b.CKV, WT(WS_WUKV), CH, 2048, 256, 256}; pg8::StaticOrder S; S.init(CH, 2048, G, bid); EpiKV E{b}; pg8::gemm_phase(lds, g, S, E); }
      }
      for (int rep_ = 0; rep_ < DUP_R1; ++rep_)
      if (PM(12)) for (int it = bid; it < CH / 32; it += G) { MKB; const int h = it & 3; ret_kv_item(b, it, lg2_of(kargs()->in[4], h), lg2_of(kargs()->in[5], h), ldsg); }
    }
    PHASE_BEGIN(run);
    if (run && PM(3)) {
      if (PM(13)) { MKB; TIDS; ret_scan(b, nseq, NC, kargs()->in[4], kargs()->in[5], bid * 512 + tid, G * 512); }
      const int vb = (G % 8 == 0) ? (bid % 8) * (G / 8) + bid / 8 : bid;
      const int nqb = SL / 256, nunits = nseq * 8 * nqb;
      for (int rep_ = 0; rep_ < DUP_ATTN; ++rep_)
      if (PM(14)) for (int uidx = vb; uidx < nunits; uidx += G) { MKB; const int qb = uidx % nqb, hh = (uidx / nqb) & 7, s = uidx / (nqb * 8);
        const size_t t0 = (size_t)s * SL;
        att::attn_unit(b.Q + (t0 + (size_t)qb * 256) * 1536 + hh * 192, b.K + t0 * 1536 + hh * 192, b.V + t0 * 1024 + hh * 128, b.H1O + (t0 + (size_t)qb * 256) * 1024 + hh * 128, SL, ldsg, lds); }
    }
    PHASE_BEGIN(run);
    if (run && PM(4)) { for (int rep_ = 0; rep_ < DUP_R3; ++rep_) for (int it = bid; it < CH / 32; it += G) { MKB; const int h = it & 3; ret_out_item(b, it, lg2_of(kargs()->in[4], h), lg2_of(kargs()->in[5], h), kargs()->in[6], ldsg); } }
    PHASE_BEGIN(run);
    if (run && PM(5)) for (int rep_ = 0; rep_ < DUP_P5; ++rep_) {
      { MKB; WSL; pg8::Gemm g{b.URET, WT(WS_WRO), CH, 1024, 1024, 1024}; pg8::StaticOrder S; S.init(CH, 1024, G, bid); EpiGate<0> E{b}; pg8::gemm_phase(lds, g, S, E); }
      { MKB; WSL; pg8::Gemm g{b.H1O, WT(WS_WMO), CH, 1024, 1024, 1024}; pg8::StaticOrder S; S.init(CH, 1024, G, bid); EpiGate<1> E{b}; pg8::gemm_phase(lds, g, S, E); }
    }
    PHASE_BEGIN(run);
    if (run && PM(6)) for (int rep_ = 0; rep_ < DUP_P69; ++rep_) { MKB; WSL; pg8::Gemm g{b.RV, WT(WS_WOUT), CH, 1024, 1024, 1024}; pg8::StaticOrder S; S.init(CH, 1024, G, bid); EpiOut E{b, rep_ == 0}; pg8::gemm_phase(lds, g, S, E); }
    PHASE_BEGIN(run);
    if (run && PM(7)) for (int rep_ = 0; rep_ < DUP_P7; ++rep_) { MKB; WSL; pg8::Gemm g{b.RG, WT(WS_WUP), CH, N_UP, 1024, 1024}; pg8::StaticOrder S; S.init(CH, N_UP, G, bid); EpiUp E{b}; pg8::gemm_phase(lds, g, S, E); }
    PHASE_BEGIN(run);
    if (run && PM(8)) for (int rep_ = 0; rep_ < DUP_P8; ++rep_) { MKB; TIDS; conv_gate(b, kargs()->in[18], kargs()->in[19], CH, bid, G, tid); }
    PHASE_BEGIN(run);
    if (run && PM(9)) {
      for (int rep_ = 0; rep_ < DUP_P69; ++rep_) { MKB; WSL; pg8::Gemm g{b.G, WT(WS_WDN), CH, 1024, DFF, DFF}; pg8::StaticOrder S; S.init(CH, 1024, G, bid); EpiDown E{b, rep_ == 0}; pg8::gemm_phase(lds, g, S, E); }
      if (chunk + 1 < nchunk) { TIDS; const Bufs nb = make_bufs<CH>(kargs(), chunk + 1); h1_rows(nb, kargs()->in[2], CH, bid * 8 + wid, G * 8, lane); }
    }
  }
}

extern "C" void kernel_launch(void* const* d_in, const int* in_sizes, int n_in, void* d_out, int out_size,
                              void* d_ws, size_t ws_size, hipStream_t stream) {
  static int grid_blocks = 0;
  if (!grid_blocks) {
    int dev = 0, cus = 0, per_cu = 0;
    (void)hipGetDevice(&dev);
    (void)hipDeviceGetAttribute(&cus, hipDeviceAttributeMultiprocessorCount, dev);
    (void)hipFuncSetAttribute((const void*)fwd_kernel<32768>, hipFuncAttributeMaxDynamicSharedMemorySize, LDS_BYTES);
    (void)hipFuncSetAttribute((const void*)fwd_kernel<16384>, hipFuncAttributeMaxDynamicSharedMemorySize, LDS_BYTES);
    (void)hipOccupancyMaxActiveBlocksPerMultiprocessor(&per_cu, fwd_kernel<32768>, 512, LDS_BYTES);
    if (per_cu < 1) per_cu = 1;
    grid_blocks = cus * per_cu;
    if (grid_blocks > 256) grid_blocks = 256;
  }
  Args a{};
  for (int i = 0; i < 21; ++i) a.in[i] = (const float*)d_in[i];
  a.out = (float*)d_out; a.ws = (unsigned char*)d_ws;
  const bool big = WS_PERM_END + (size_t)PT_END * 32768 <= ws_size;
  a.CH = big ? 32768 : 16384; a.ph_lo = 0; a.ph_hi = 0; a.pad = 0;
  void* args[] = {&a};
  hipError_t e = hipLaunchCooperativeKernel(big ? (void*)fwd_kernel<32768> : (void*)fwd_kernel<16384>, dim3(grid_blocks), dim3(512), args, LDS_BYTES, stream);
  if (e != hipSuccess) fprintf(stderr, "cooperative launch failed: %s (grid %d)\n", hipGetErrorString(e), grid_blocks);
}
```

```cpp
#include <hip/hip_runtime.h>
#include <hip/hip_cooperative_groups.h>
#include <cstdio>
#include <cstdint>
namespace cg = cooperative_groups;

#define LAS __attribute__((address_space(3)))
typedef unsigned short bf16_t;
typedef short bf16x8 __attribute__((ext_vector_type(8)));
typedef short s16x4 __attribute__((ext_vector_type(4)));
typedef float f32x4 __attribute__((ext_vector_type(4)));
typedef float f32x2 __attribute__((ext_vector_type(2)));
typedef float f32x16 __attribute__((ext_vector_type(16)));
typedef unsigned u32x4 __attribute__((ext_vector_type(4)));
typedef unsigned u32x2 __attribute__((ext_vector_type(2)));

constexpr int DM = 1024, NP = 32768, TT = 98304;
constexpr int N_IN = 5888, N_UP = 5632, DFF = 2816;
constexpr float EPS = 1e-6f;
constexpr int LDS_BYTES = 163840;
#ifndef DUP_ATTN
#define DUP_ATTN 1
#endif
#ifndef DUP_R1
#define DUP_R1 1
#endif
#ifndef DUP_R3
#define DUP_R3 1
#endif
#ifndef DUP_P5
#define DUP_P5 1
#endif
#ifndef DUP_P7
#define DUP_P7 1
#endif
#ifndef DUP_P8
#define DUP_P8 1
#endif
#ifndef DUP_P2G
#define DUP_P2G 1
#endif
#ifndef DUP_P0
#define DUP_P0 1
#endif
#ifndef DUP_P1
#define DUP_P1 1
#endif
#ifndef DUP_P69
#define DUP_P69 1
#endif
#ifndef DUP_SYNC
#define DUP_SYNC 1
#endif
#ifndef PMASK
#define PMASK 0xFFFFF
#endif
#define PM(k) ((PMASK >> (k)) & 1)

constexpr size_t al256(size_t x) { return (x + 255) / 256 * 256; }
constexpr size_t WS_WIN = 0;
constexpr size_t WS_WUQ = WS_WIN + (size_t)N_IN * 1024 * 2;
constexpr size_t WS_WUKV = WS_WUQ + (size_t)2048 * 384 * 2;
constexpr size_t WS_WRO = WS_WUKV + (size_t)2048 * 256 * 2;
constexpr size_t WS_WMO = WS_WRO + (size_t)1024 * 1024 * 2;
constexpr size_t WS_WOUT = WS_WMO + (size_t)1024 * 1024 * 2;
constexpr size_t WS_WUP = WS_WOUT + (size_t)1024 * 1024 * 2;
constexpr size_t WS_WDN = WS_WUP + (size_t)N_UP * 1024 * 2;
constexpr size_t WS_ROPE = WS_WDN + (size_t)1024 * DFF * 2;
constexpr size_t WS_SSQ = WS_ROPE + (size_t)8192 * 64 * 8;
constexpr size_t WS_GP = WS_SSQ + (size_t)30 * TT * 4;
constexpr size_t WS_BAR = al256(WS_GP + 2048);
constexpr size_t WS_PERM_END = al256(WS_BAR + 16384);
constexpr size_t PT_H1O = 0, PT_RG = 2048, PT_RQ = 4096, PT_RK = 5120, PT_RV = 6144, PT_GR = 8192, PT_GA = 10240, PT_CQ = 12288, PT_CKV = 13056,
                 PT_KR = 13568, PT_Q = 13696, PT_K = 16768, PT_V = 19840, PT_URET = 21888, PT_KV = 23936, PT_END = 28032;
constexpr size_t PT_UR = PT_RQ, PT_G = PT_RQ + 11264;
static_assert(PT_G + 5632 <= PT_END, "ffn overlay");

struct Args { const float* in[21]; float* out; unsigned char* ws; int CH; int ph_lo; int ph_hi; int pad; };

__device__ __forceinline__ unsigned cvt_pk(float lo, float hi) { unsigned r; asm volatile("v_cvt_pk_bf16_f32 %0, %1, %2" : "=v"(r) : "v"(lo), "v"(hi)); return r; }
__device__ __forceinline__ float bflo(unsigned w) { return __uint_as_float(w << 16); }
__device__ __forceinline__ float bfhi(unsigned w) { return __uint_as_float(w & 0xffff0000u); }
__device__ __forceinline__ void st8(bf16_t* p, f32x4 a, f32x4 b) { u32x4 w = {cvt_pk(a[0], a[1]), cvt_pk(a[2], a[3]), cvt_pk(b[0], b[1]), cvt_pk(b[2], b[3])}; *(u32x4*)p = w; }
__device__ __forceinline__ void ld8(const bf16_t* p, f32x4& a, f32x4& b) { u32x4 w = *(const u32x4*)p; a = (f32x4){bflo(w.x), bfhi(w.x), bflo(w.y), bfhi(w.y)}; b = (f32x4){bflo(w.z), bfhi(w.z), bflo(w.w), bfhi(w.w)}; }
__device__ __forceinline__ float sigm(float x) { return __builtin_amdgcn_rcpf(1.f + __builtin_amdgcn_exp2f(x * -1.4426950408889634f)); }
typedef __bf16 bf16x2_t __attribute__((ext_vector_type(2)));
__device__ __forceinline__ unsigned cvt_pk_s(float lo, float hi) { f32x2 v = {lo, hi}; bf16x2_t b = __builtin_convertvector(v, bf16x2_t); return __builtin_bit_cast(unsigned, b); }
__device__ __forceinline__ void st8_s(bf16_t* p, f32x4 a, f32x4 b) { u32x4 w = {cvt_pk_s(a[0], a[1]), cvt_pk_s(a[2], a[3]), cvt_pk_s(b[0], b[1]), cvt_pk_s(b[2], b[3])}; *(u32x4*)p = w; }
__device__ __forceinline__ float wave_sum(float v) {
#pragma unroll
  for (int o = 1; o < 64; o <<= 1) v += __shfl_xor(v, o);
  return v;
}
__device__ __forceinline__ float dot4(f32x4 a) { return (a[0] * a[0] + a[1] * a[1]) + (a[2] * a[2] + a[3] * a[3]); }
__device__ __forceinline__ void lds_barrier() { asm volatile("s_waitcnt lgkmcnt(0)" ::: "memory"); __builtin_amdgcn_s_barrier(); asm volatile("" ::: "memory"); }

struct Bufs {
  bf16_t *H1O, *RG, *RQ, *RK, *RV, *GR, *GA, *CQ, *CKV, *KR, *Q, *K, *V, *URET, *KV, *UR, *G;
  const float* rope; float *ssq_cq, *ssq_ckv, *ssq_kr, *ssq_x1; const float *gqp, *gkp;
  const float *xp, *xs; float* out;
  int g0, slm;
};
__device__ __forceinline__ const float* xrow(const Bufs& b, int g) { return g < NP ? b.xp + (size_t)g * DM : b.xs + (size_t)(g - NP) * DM; }

namespace pg8 {
constexpr int BM = 256, BK = 64, HALF = 128, HTB = HALF * BK * 2, STAGE_BYTES = 8 * HTB, NXCD = 8, WGM = 8;
__host__ __device__ __forceinline__ int lds_byte(int r, int c) { const int st = (r >> 4) * 2 + (c >> 5), rr = r & 15, cc = c & 31, ob = rr * 64 + cc * 2; return st * 1024 + (ob ^ (((ob >> 9) & 1) << 5)); }
__host__ __device__ __forceinline__ void stage_rc(int b, int& R, int& C) { const int st = b / 1024, sb = b % 1024, swz = sb ^ (((sb >> 9) & 1) << 5); R = (st >> 1) * 16 + swz / 64; C = (st & 1) * 32 + (swz % 64) / 2; }
__host__ __device__ __forceinline__ int perm32(int rho) { const int n = rho >> 4, i = rho & 15; return 8 * (i >> 2) + 4 * n + (i & 3); }
struct Unit { int pm, pn; };
struct Gemm { const bf16_t* A; const bf16_t* Bt; int M, N, K, lda; };
struct StaticOrder {
  int nM, nN, nwg, G, c;
  __device__ void init(int M, int N, int G_, int c_) { nM = M / BM; nN = N / BM; nwg = nM * nN; G = G_; c = c_; }
  __device__ bool next(int i, Unit& u) const {
    const long L = (long)i * G + c; if (L >= nwg) return false;
    int wgid = (int)L; { const int q = nwg / NXCD, r = nwg % NXCD, xcd = wgid % NXCD, off = wgid / NXCD; wgid = (xcd < r ? xcd * (q + 1) : r * (q + 1) + (xcd - r) * q) + off; }
    const int nig = WGM * nN, gid = wgid / nig, fm = gid * WGM, gsz = (nM - fm) < WGM ? (nM - fm) : WGM;
    u.pm = fm + ((wgid % nig) % gsz); u.pn = (wgid % nig) / gsz; return true;
  }
};

template <class Epi, class Sched>
__device__ __forceinline__ void gemm_phase(LAS unsigned char* lds, const Gemm g, const Sched& S, const Epi& E) {
  constexpr bool ALIGN_EPI = true;
  int tid_ = threadIdx.x; asm volatile("" : "+v"(tid_));
  const int tid = tid_, wid = __builtin_amdgcn_readfirstlane(tid >> 6), lane = tid & 63, wr = wid >> 2, wc = wid & 3, fr = lane & 15, fq = lane >> 4;
  int K = g.K; asm volatile("" : "+s"(K)); const int nt = K / BK, lda = g.lda;
  unsigned voffA[2], voffB[2];
#pragma unroll
  for (int i = 0; i < 2; ++i) { int R, C; stage_rc(tid * 16 + i * 8192, R, C); const int Rb = (R & ~31) + perm32(R & 31);
    voffA[i] = (unsigned)(R * lda + C) * 2u; voffB[i] = (unsigned)(Rb * K + C) * 2u; }
  const size_t kstep = (size_t)(BK * 2);
  const size_t hstepA = (size_t)HALF * lda * 2, tstepA = 2 * hstepA;
  const size_t hstepB = (size_t)HALF * K * 2, tstepB = 2 * hstepB;
  const unsigned ldsw = (unsigned)wid * 1024u;
  const int aoff = lds_byte(wr * 64 + fr, fq * 8), boff = lds_byte(wc * 32 + fr, fq * 8);
#define PG8_SA(b, h) (((b) * 2 + (h)) * HTB)
#define PG8_SB(b, h) ((4 + (b) * 2 + (h)) * HTB)
#define PG8_STAGE(bufoff, gbase, voff) do { _Pragma("unroll") for (int _i = 0; _i < 2; ++_i) \
    __builtin_amdgcn_global_load_lds((const unsigned*)((const char*)(gbase) + (voff)[_i]), (LAS unsigned*)(lds + (bufoff) + ldsw + _i * 8192), 16, 0, 0); } while (0)
#define PG8_LDA(dst, b, h) do { _Pragma("unroll") for (int m = 0; m < 4; ++m) _Pragma("unroll") for (int k = 0; k < 2; ++k) dst[m][k] = *(const LAS bf16x8*)(lds + PG8_SA(b, h) + aoff + m * 2048 + k * 1024); } while (0)
#define PG8_LDB(dst, b, h) do { _Pragma("unroll") for (int n = 0; n < 2; ++n) _Pragma("unroll") for (int k = 0; k < 2; ++k) dst[n][k] = *(const LAS bf16x8*)(lds + PG8_SB(b, h) + boff + n * 2048 + k * 1024); } while (0)
#define PG8_MMA(ai, bj, At, Bt) do { __builtin_amdgcn_s_setprio(1); _Pragma("unroll") for (int m = 0; m < 4; ++m) _Pragma("unroll") for (int n = 0; n < 2; ++n) _Pragma("unroll") for (int k = 0; k < 2; ++k) \
    acc[ai][bj][m][n] = __builtin_amdgcn_mfma_f32_16x16x32_bf16(Bt[n][k], At[m][k], acc[ai][bj][m][n], 0, 0, 0); __builtin_amdgcn_s_setprio(0); } while (0)
#define PG8_WAIT_V(n) asm volatile("s_waitcnt vmcnt(" #n ")" ::: "memory")
#define PG8_WAIT_L(n) asm volatile("s_waitcnt lgkmcnt(" #n ")" ::: "memory")
#define PG8_BAR __builtin_amdgcn_s_barrier()
#define PG8_SCHED __builtin_amdgcn_sched_barrier(0)
  Unit cur, nxt; int ui = 0;
  if (!S.next(0, cur)) return;
  f32x4 acc[2][2][4][2];
#pragma unroll
  for (int a = 0; a < 2; ++a)
#pragma unroll
    for (int b = 0; b < 2; ++b)
#pragma unroll
      for (int m = 0; m < 4; ++m)
#pragma unroll
        for (int n = 0; n < 2; ++n) acc[a][b][m][n] = (f32x4){0.f, 0.f, 0.f, 0.f};
  bf16x8 At[4][2], B0[2][2], B1[2][2];
  const char* cA = (const char*)g.A + (size_t)cur.pm * tstepA; const char* cB = (const char*)g.Bt + (size_t)cur.pn * tstepB;
  PG8_STAGE(PG8_SB(0, 0), cB, voffB); PG8_STAGE(PG8_SB(0, 1), cB + hstepB, voffB); PG8_STAGE(PG8_SA(0, 0), cA, voffA); PG8_STAGE(PG8_SA(0, 1), cA + hstepA, voffA);
  if (wr == 1) PG8_BAR;
  PG8_WAIT_V(2); PG8_BAR;
  PG8_STAGE(PG8_SB(1, 0), cB + kstep, voffB); PG8_STAGE(PG8_SA(1, 0), cA + kstep, voffA); PG8_STAGE(PG8_SB(1, 1), cB + hstepB + kstep, voffB);
  PG8_WAIT_V(6); PG8_BAR;
  for (;;) {
    const bool has_next = S.next(ui + 1, nxt);
    const char* nA = has_next ? (const char*)g.A + (size_t)nxt.pm * tstepA : cA; const char* nB = has_next ? (const char*)g.Bt + (size_t)nxt.pn * tstepB : cB;
    for (int t = 0; t < nt; t += 2) {
      const bool last = (t == nt - 2);
      const char* a1 = cA + (size_t)(t + 1) * kstep;
      const char* a2 = last ? nA : cA + (size_t)(t + 2) * kstep; const char* b2 = last ? nB : cB + (size_t)(t + 2) * kstep;
      const char* a3 = a2 + kstep; const char* b3 = b2 + kstep;
      PG8_LDB(B0, 0, 0); PG8_LDB(B1, 0, 1); PG8_SCHED; PG8_LDA(At, 0, 0); PG8_STAGE(PG8_SA(1, 1), a1 + hstepA, voffA);
      PG8_WAIT_V(8); PG8_WAIT_L(0); PG8_BAR; PG8_MMA(0, 0, At, B0); PG8_MMA(0, 1, At, B1); PG8_BAR; PG8_SCHED;
      PG8_LDA(At, 0, 1); PG8_STAGE(PG8_SB(0, 0), b2, voffB); PG8_STAGE(PG8_SB(0, 1), b2 + hstepB, voffB); PG8_STAGE(PG8_SA(0, 0), a2, voffA);
      PG8_WAIT_V(8); PG8_WAIT_L(0); PG8_BAR; PG8_MMA(1, 0, At, B0); PG8_MMA(1, 1, At, B1); PG8_BAR; PG8_SCHED;
      PG8_LDB(B0, 1, 0); PG8_LDB(B1, 1, 1); PG8_SCHED; PG8_LDA(At, 1, 0); PG8_STAGE(PG8_SA(0, 1), a2 + hstepA, voffA);
      PG8_WAIT_V(8); PG8_WAIT_L(0); PG8_BAR; PG8_MMA(0, 0, At, B0); PG8_MMA(0, 1, At, B1); PG8_BAR; PG8_SCHED;
      PG8_LDA(At, 1, 1); PG8_STAGE(PG8_SB(1, 0), b3, voffB); PG8_STAGE(PG8_SB(1, 1), b3 + hstepB, voffB); PG8_STAGE(PG8_SA(1, 0), a3, voffA);
      PG8_WAIT_V(8); PG8_WAIT_L(0); PG8_BAR; PG8_MMA(1, 0, At, B0); PG8_MMA(1, 1, At, B1); PG8_BAR; PG8_SCHED;
    }
    if constexpr (ALIGN_EPI) { if (wr == 0) PG8_BAR; }
    { int fr2 = fr, fq2 = fq; asm volatile("" : "+v"(fr2), "+v"(fq2)); E(acc, cur, wr, wc, fr2, fq2, lds + STAGE_BYTES); }
    if (!has_next) break;
#pragma unroll
    for (int a = 0; a < 2; ++a)
#pragma unroll
      for (int b = 0; b < 2; ++b)
#pragma unroll
        for (int m = 0; m < 4; ++m)
#pragma unroll
          for (int n = 0; n < 2; ++n) acc[a][b][m][n] = (f32x4){0.f, 0.f, 0.f, 0.f};
    cur = nxt; cA = nA; cB = nB; ++ui;
    if constexpr (ALIGN_EPI) { if (wr == 1) PG8_BAR; }
  }
  PG8_WAIT_V(0);
  if constexpr (!ALIGN_EPI) { if (wr == 0) PG8_BAR; }
  PG8_BAR;
#undef PG8_SA
#undef PG8_SB
#undef PG8_STAGE
#undef PG8_LDA
#undef PG8_LDB
#undef PG8_MMA
#undef PG8_WAIT_V
#undef PG8_WAIT_L
#undef PG8_BAR
#undef PG8_SCHED
}
}
using pg8::Unit;

#define SBAR0() __builtin_amdgcn_sched_barrier(0)
#define EPI_ARGS const f32x4 (&acc)[2][2][4][2], const Unit& u, int wr, int wc, int fr, int fq, LAS unsigned char* scr
#define FOR_AI_M _Pragma("unroll") for (int ai = 0; ai < 2; ++ai) if ((__builtin_amdgcn_sched_barrier(0), true)) _Pragma("unroll") for (int m = 0; m < 4; ++m)

__device__ __forceinline__ void rope4(f32x4& v0, f32x4& v1, f32x4 t0, f32x4 t1) {
  f32x4 o0 = {v0[0] * t0[0] - v0[1] * t0[1], v0[0] * t0[1] + v0[1] * t0[0], v0[2] * t0[2] - v0[3] * t0[3], v0[2] * t0[3] + v0[3] * t0[2]};
  f32x4 o1 = {v1[0] * t1[0] - v1[1] * t1[1], v1[0] * t1[1] + v1[1] * t1[0], v1[2] * t1[2] - v1[3] * t1[3], v1[2] * t1[3] + v1[3] * t1[2]};
  v0 = o0; v1 = o1;
}

struct EpiIn {
  Bufs b; bool at;
  __device__ __forceinline__ void rope_store(const f32x4 (&acc)[2][2][4][2], bf16_t* dst, float sc, int hsel, int rbase, int wc, int fq) const {
    const int c0 = wc * 32 + fq * 8, i0 = wc * 16 + fq * 4;
    FOR_AI_M { const int row = rbase + ai * 128 + m * 16, pos = (b.g0 + row) & b.slm;
      const f32x4* tp = (const f32x4*)(b.rope + ((size_t)pos * 64 + i0) * 2); const f32x4 t0 = tp[0], t1 = tp[1];
#pragma unroll
      for (int bj = 0; bj < 2; ++bj) { f32x4 v0 = acc[ai][bj][m][0], v1 = acc[ai][bj][m][1]; rope4(v0, v1, t0, t1);
        st8(dst + (size_t)row * 512 + (hsel * 2 + bj) * 128 + c0, v0 * sc, v1 * sc); } }
  }
  template <int ACT> __device__ __forceinline__ void plain_store(const f32x4 (&acc)[2][2][4][2], bf16_t* dst, int cbase, int rbase) const {
    FOR_AI_M { const int row = rbase + ai * 128 + m * 16;
#pragma unroll
      for (int bj = 0; bj < 2; ++bj) { f32x4 v0 = acc[ai][bj][m][0], v1 = acc[ai][bj][m][1];
        if (ACT == 1) {
#pragma unroll
          for (int e = 0; e < 4; ++e) { v0[e] = v0[e] * sigm(v0[e]); v1[e] = v1[e] * sigm(v1[e]); } }
        if (ACT == 2) {
#pragma unroll
          for (int e = 0; e < 4; ++e) { v0[e] = sigm(v0[e]); v1[e] = sigm(v1[e]); } }
        if (ACT == 0) st8(dst + (size_t)row * 1024 + cbase + bj * 128, v0, v1); else st8_s(dst + (size_t)row * 1024 + cbase + bj * 128, v0, v1); } }
  }
  __device__ __forceinline__ void ssq_store(const f32x4 (&acc)[2][2][4][2], bf16_t* dst, int ld, float* sq, int ns, int slot, int rbase, int c0, int fq) const {
    FOR_AI_M { const int row = rbase + ai * 128 + m * 16; float s = 0.f;
#pragma unroll
      for (int bj = 0; bj < 2; ++bj) { const f32x4 v0 = acc[ai][bj][m][0], v1 = acc[ai][bj][m][1]; s += dot4(v0) + dot4(v1); st8(dst + (size_t)row * ld + bj * 128 + c0, v0, v1); }
      s += __shfl_xor(s, 16); s += __shfl_xor(s, 32); if (fq == 0 && at) sq[(size_t)(b.g0 + row) * ns + slot] = s; }
  }
  __device__ __forceinline__ void operator()(EPI_ARGS) const {
    const int pn = u.pn, rbase = u.pm * 256 + wr * 64 + fr, c0 = wc * 32 + fq * 8;
    if (pn < 2) rope_store(acc, b.RQ, 1.f, pn, rbase, wc, fq);
    else if (pn < 4) rope_store(acc, b.RK, 0.08838834764831845f, pn - 2, rbase, wc, fq);
    else if (pn < 8) plain_store<0>(acc, b.RV, (pn - 4) * 256 + c0, rbase);
    else if (pn < 12) plain_store<1>(acc, b.RG, (pn - 8) * 256 + c0, rbase);
    else if (pn < 16) plain_store<2>(acc, b.GR, (pn - 12) * 256 + c0, rbase);
    else if (pn < 20) plain_store<2>(acc, b.GA, (pn - 16) * 256 + c0, rbase);
    else if (pn == 20) ssq_store(acc, b.CQ, 384, b.ssq_cq, 8, wc, rbase, c0, fq);
    else if (pn == 22) ssq_store(acc, b.CKV, 256, b.ssq_ckv, 4, wc, rbase, c0, fq);
    else {
      FOR_AI_M { const int row = rbase + ai * 128 + m * 16, pos = (b.g0 + row) & b.slm;
        { const f32x4 v0 = acc[ai][0][m][0], v1 = acc[ai][0][m][1]; float s = dot4(v0) + dot4(v1); st8(b.CQ + (size_t)row * 384 + 256 + c0, v0, v1);
          s += __shfl_xor(s, 16); s += __shfl_xor(s, 32); if (fq == 0 && at) b.ssq_cq[(size_t)(b.g0 + row) * 8 + 4 + wc] = s; }
        if (wc < 2) { f32x4 v0 = acc[ai][1][m][0], v1 = acc[ai][1][m][1]; const int j0 = wc * 16 + fq * 4;
          const f32x2* tp = (const f32x2*)(b.rope + ((size_t)pos * 64 + 2 * j0) * 2); const f32x2 a0 = tp[0], a1 = tp[2], a2 = tp[4], a3 = tp[6];
          rope4(v0, v1, (f32x4){a0[0], a0[1], a1[0], a1[1]}, (f32x4){a2[0], a2[1], a3[0], a3[1]});
          float s = dot4(v0) + dot4(v1); st8(b.KR + (size_t)row * 64 + c0, v0, v1);
          s += __shfl_xor(s, 16); s += __shfl_xor(s, 32); if (fq == 0 && at) b.ssq_kr[(size_t)(b.g0 + row) * 2 + wc] = s; } }
    }
  }
};

__device__ __forceinline__ void xwave_rowsum(float (&part)[8], int wr, int wc, int fr, int fq, LAS unsigned char* scr) {
  LAS float* red = (LAS float*)scr;
  if (fq == 0) {
#pragma unroll
    for (int i = 0; i < 8; ++i) red[((wr * 4 + wc) * 8 + i) * 16 + fr] = part[i];
  }
  lds_barrier();
#pragma unroll
  for (int i = 0; i < 8; ++i) part[i] = (red[((wr * 4 + 0) * 8 + i) * 16 + fr] + red[((wr * 4 + 1) * 8 + i) * 16 + fr]) + (red[((wr * 4 + 2) * 8 + i) * 16 + fr] + red[((wr * 4 + 3) * 8 + i) * 16 + fr]);
}

struct EpiQ {
  Bufs b;
  __device__ __forceinline__ void operator()(EPI_ARGS) const {
    const int head = u.pn, rbase = u.pm * 256 + wr * 64 + fr, c0 = wc * 32 + fq * 8;
    float part[8];
    FOR_AI_M { float s = 0.f;
#pragma unroll
      for (int bj = 0; bj < 2; ++bj) s += dot4(acc[ai][bj][m][0]) + dot4(acc[ai][bj][m][1]);
      s += __shfl_xor(s, 16); s += __shfl_xor(s, 32); part[ai * 4 + m] = s; }
    xwave_rowsum(part, wr, wc, fr, fq, scr);
    const float* gqp = b.gqp; asm volatile("" : "+s"(gqp));
    const f32x4 g0 = *(const f32x4*)(gqp + c0), g1 = *(const f32x4*)(gqp + c0 + 4), h0 = *(const f32x4*)(gqp + 128 + c0), h1 = *(const f32x4*)(gqp + 128 + c0 + 4);
    FOR_AI_M { const int i = ai * 4 + m, row = rbase + ai * 128 + m * 16, pos = (b.g0 + row) & b.slm;
      const f32x4* sp = (const f32x4*)(b.ssq_cq + (size_t)(b.g0 + row) * 8); const f32x4 s0 = sp[0], s1 = sp[1];
      const float r1 = rsqrtf((((s0[0] + s0[1]) + (s0[2] + s0[3])) + ((s1[0] + s1[1]) + (s1[2] + s1[3]))) * (1.f / 384.f) + EPS);
      const float f = r1 * rsqrtf(r1 * r1 * part[i] * (1.f / 192.f) + EPS) * 0.10411754002f;
      bf16_t* qp = b.Q + (size_t)row * 1536 + head * 192;
      st8(qp + c0, acc[ai][0][m][0] * g0 * f, acc[ai][0][m][1] * g1 * f);
      if (wc < 2) { f32x4 v0 = acc[ai][1][m][0] * h0 * f, v1 = acc[ai][1][m][1] * h1 * f; const int j0 = wc * 16 + fq * 4;
        const f32x2* tp = (const f32x2*)(b.rope + ((size_t)pos * 64 + 2 * j0) * 2); const f32x2 a0 = tp[0], a1 = tp[2], a2 = tp[4], a3 = tp[6];
        rope4(v0, v1, (f32x4){a0[0], a0[1], a1[0], a1[1]}, (f32x4){a2[0], a2[1], a3[0], a3[1]});
        st8(qp + 128 + c0, v0, v1); } }
  }
};

struct EpiKV {
  Bufs b;
  __device__ __forceinline__ void operator()(EPI_ARGS) const {
    const int head = u.pn, rbase = u.pm * 256 + wr * 64 + fr, c0 = wc * 32 + fq * 8;
    float part[8], rs[8];
    FOR_AI_M { const int row = rbase + ai * 128 + m * 16; { const f32x4 s0 = *(const f32x4*)(b.ssq_ckv + (size_t)(b.g0 + row) * 4); rs[ai * 4 + m] = rsqrtf(((s0[0] + s0[1]) + (s0[2] + s0[3])) * (1.f / 256.f) + EPS); }
      float s = dot4(acc[ai][0][m][0]) + dot4(acc[ai][0][m][1]);
      s += __shfl_xor(s, 16); s += __shfl_xor(s, 32); part[ai * 4 + m] = s; }
    xwave_rowsum(part, wr, wc, fr, fq, scr);
    const float* gkp = b.gkp; asm volatile("" : "+s"(gkp));
    const f32x4 g0 = *(const f32x4*)(gkp + c0), g1 = *(const f32x4*)(gkp + c0 + 4);
    const int kc0 = (wc * 4 + fq) * 4; const f32x4 gr = *(const f32x4*)(gkp + 128 + kc0);
    FOR_AI_M { const int i = ai * 4 + m, row = rbase + ai * 128 + m * 16, pos = (b.g0 + row) & b.slm;
      const float r1 = rs[i], rsk = rsqrtf((r1 * r1 * part[i] + (b.ssq_kr[(size_t)(b.g0 + row) * 2] + b.ssq_kr[(size_t)(b.g0 + row) * 2 + 1])) * (1.f / 192.f) + EPS), f = r1 * rsk;
      bf16_t* kp = b.K + (size_t)row * 1536 + head * 192;
      st8(kp + c0, acc[ai][0][m][0] * g0 * f, acc[ai][0][m][1] * g1 * f);
      st8(b.V + (size_t)row * 1024 + head * 128 + c0, acc[ai][1][m][0] * r1, acc[ai][1][m][1] * r1);
      const u32x2 w = *(const u32x2*)(b.KR + (size_t)row * 64 + kc0);
      const float x0 = bflo(w.x) * gr[0], y0 = bfhi(w.x) * gr[1], x1 = bflo(w.y) * gr[2], y1 = bfhi(w.y) * gr[3];
      const f32x2* tp = (const f32x2*)(b.rope + ((size_t)pos * 64 + kc0) * 2); const f32x2 a0 = tp[0], a1 = tp[2];
      u32x2 o; o.x = cvt_pk((x0 * a0[0] - y0 * a0[1]) * rsk, (x0 * a0[1] + y0 * a0[0]) * rsk); o.y = cvt_pk((x1 * a1[0] - y1 * a1[1]) * rsk, (x1 * a1[1] + y1 * a1[0]) * rsk);
      *(u32x2*)(kp + 128 + kc0) = o; }
  }
};

template <int mode> struct EpiGate {
  Bufs b;
  __device__ __forceinline__ void operator()(EPI_ARGS) const {
    const int rbase = u.pm * 256 + wr * 64 + fr, c0 = u.pn * 256 + wc * 32 + fq * 8; const bf16_t* gate = mode ? b.GA : b.GR; bf16_t* mg = b.RV;
#pragma unroll
    for (int ai = 0; ai < 2; ++ai) {
      SBAR0();
      u32x4 gt[4][2], pv[4][2];
#pragma unroll
      for (int m = 0; m < 4; ++m)
#pragma unroll
        for (int bj = 0; bj < 2; ++bj) { const size_t idx = (size_t)(rbase + ai * 128 + m * 16) * 1024 + c0 + bj * 128; gt[m][bj] = *(const u32x4*)(gate + idx); if (mode) pv[m][bj] = *(const u32x4*)(mg + idx); }
#pragma unroll
      for (int m = 0; m < 4; ++m)
#pragma unroll
        for (int bj = 0; bj < 2; ++bj) { const size_t idx = (size_t)(rbase + ai * 128 + m * 16) * 1024 + c0 + bj * 128; const u32x4 g = gt[m][bj];
          f32x4 v0 = acc[ai][bj][m][0] * (f32x4){bflo(g.x), bfhi(g.x), bflo(g.y), bfhi(g.y)}, v1 = acc[ai][bj][m][1] * (f32x4){bflo(g.z), bfhi(g.z), bflo(g.w), bfhi(g.w)};
          if (mode) { const u32x4 p = pv[m][bj]; v0 += (f32x4){bflo(p.x), bfhi(p.x), bflo(p.y), bfhi(p.y)}; v1 += (f32x4){bflo(p.z), bfhi(p.z), bflo(p.w), bfhi(p.w)}; }
          st8(mg + idx, v0, v1); }
    }
  }
};

struct EpiOut {
  Bufs b; bool at;
  __device__ __forceinline__ void operator()(EPI_ARGS) const {
    const int rbase = u.pm * 256 + wr * 64 + fr, c0 = u.pn * 256 + wc * 32 + fq * 8;
#pragma unroll
    for (int ai = 0; ai < 2; ++ai) {
      SBAR0();
      f32x4 xv[4][2][2];
#pragma unroll
      for (int m = 0; m < 4; ++m) { const float* xr = xrow(b, b.g0 + rbase + ai * 128 + m * 16);
#pragma unroll
        for (int bj = 0; bj < 2; ++bj) { xv[m][bj][0] = *(const f32x4*)(xr + c0 + bj * 128); xv[m][bj][1] = *(const f32x4*)(xr + c0 + bj * 128 + 4); } }
#pragma unroll
      for (int m = 0; m < 4; ++m) { const int row = rbase + ai * 128 + m * 16, g = b.g0 + row; float s = 0.f;
#pragma unroll
        for (int bj = 0; bj < 2; ++bj) { const int c = c0 + bj * 128; const f32x4 v0 = acc[ai][bj][m][0] + xv[m][bj][0], v1 = acc[ai][bj][m][1] + xv[m][bj][1];
          st8(b.RG + (size_t)row * 1024 + c, v0, v1); s += dot4(v0) + dot4(v1); }
        s += __shfl_xor(s, 16); s += __shfl_xor(s, 32); if (fq == 0 && at) b.ssq_x1[(size_t)g * 16 + u.pn * 4 + wc] = s; }
    }
  }
};

struct EpiUp {
  Bufs b;
  __device__ __forceinline__ void operator()(EPI_ARGS) const {
    const int rbase = u.pm * 256 + wr * 64 + fr, c0 = u.pn * 256 + wc * 32 + fq * 8;
    FOR_AI_M { const int row = rbase + ai * 128 + m * 16; const f32x4* sp = (const f32x4*)(b.ssq_x1 + (size_t)(b.g0 + row) * 16); const f32x4 q0 = sp[0], q1 = sp[1], q2 = sp[2], q3 = sp[3];
      const float r2 = rsqrtf(((((q0[0] + q0[1]) + (q0[2] + q0[3])) + ((q1[0] + q1[1]) + (q1[2] + q1[3]))) + (((q2[0] + q2[1]) + (q2[2] + q2[3])) + ((q3[0] + q3[1]) + (q3[2] + q3[3])))) * (1.f / 1024.f) + EPS);
#pragma unroll
      for (int bj = 0; bj < 2; ++bj) st8(b.UR + (size_t)row * N_UP + c0 + bj * 128, acc[ai][bj][m][0] * r2, acc[ai][bj][m][1] * r2); }
  }
};

struct EpiDown {
  Bufs b; bool at;
  __device__ __forceinline__ void operator()(EPI_ARGS) const {
    const int rbase = u.pm * 256 + wr * 64 + fr, c0 = u.pn * 256 + wc * 32 + fq * 8;
#pragma unroll
    for (int ai = 0; ai < 2; ++ai) {
      SBAR0();
      u32x4 xv[4][2];
#pragma unroll
      for (int m = 0; m < 4; ++m)
#pragma unroll
        for (int bj = 0; bj < 2; ++bj) xv[m][bj] = *(const u32x4*)(b.RG + (size_t)(rbase + ai * 128 + m * 16) * 1024 + c0 + bj * 128);
      if (at) {
#pragma unroll
        for (int m = 0; m < 4; ++m) { float* orow = b.out + (size_t)(b.g0 + rbase + ai * 128 + m * 16) * DM;
#pragma unroll
          for (int bj = 0; bj < 2; ++bj) { const int c = c0 + bj * 128; const u32x4 p = xv[m][bj];
            *(f32x4*)(orow + c) = (f32x4){bflo(p.x), bfhi(p.x), bflo(p.y), bfhi(p.y)} + acc[ai][bj][m][0]; *(f32x4*)(orow + c + 4) = (f32x4){bflo(p.z), bfhi(p.z), bflo(p.w), bfhi(p.w)} + acc[ai][bj][m][1]; } }
      }
    }
  }
};

#define SBAR() __builtin_amdgcn_sched_barrier(0)
__device__ __forceinline__ int crow(int r, int hi) { return (r & 3) + 8 * (r >> 2) + 4 * hi; }
__device__ __forceinline__ int v_st(int k, int c) { const int kk = (k & ~0xC) | ((k & 4) << 1) | ((k & 8) >> 1); return ((kk >> 3) * 4 + (c >> 5)) * 512 + ((kk & 7) * 32 + (c & 31)) * 2; }
__device__ __forceinline__ int v_rd_base(int lane) { return ((lane & 3) << 3) | (((lane >> 2) & 3) << 6) | (((lane >> 4) & 1) << 5) | (((lane >> 5) & 1) << 8); }
constexpr int v_rd_off(int d0, int ks, int half) { return d0 * 512 + ks * 4096 + half * 2048; }
template <int OFF> __device__ __forceinline__ s16x4 tr_read(int vb) {
  s16x4 r; asm volatile("ds_read_b64_tr_b16 %0, %1 offset:%2" : "=&v"(r) : "v"(vb), "i"(OFF) : "memory"); return r;
}
#define PKLH(L, H) (bf16x8){L[0], L[1], L[2], L[3], H[0], H[1], H[2], H[3]}
template <int D0> __device__ __forceinline__ void pv_one(f32x16& od, int vb, bf16x8 pa0, bf16x8 pa1, bf16x8 pa2, bf16x8 pa3) {
  const s16x4 l0 = tr_read<v_rd_off(D0, 0, 0)>(vb), h0 = tr_read<v_rd_off(D0, 0, 1)>(vb), l1 = tr_read<v_rd_off(D0, 1, 0)>(vb), h1 = tr_read<v_rd_off(D0, 1, 1)>(vb);
  const s16x4 l2 = tr_read<v_rd_off(D0, 2, 0)>(vb), h2 = tr_read<v_rd_off(D0, 2, 1)>(vb), l3 = tr_read<v_rd_off(D0, 3, 0)>(vb), h3 = tr_read<v_rd_off(D0, 3, 1)>(vb);
  asm volatile("s_waitcnt lgkmcnt(0)" ::: "memory"); SBAR();
  od = __builtin_amdgcn_mfma_f32_32x32x16_bf16(pa0, PKLH(l0, h0), od, 0, 0, 0);
  od = __builtin_amdgcn_mfma_f32_32x32x16_bf16(pa1, PKLH(l1, h1), od, 0, 0, 0);
  od = __builtin_amdgcn_mfma_f32_32x32x16_bf16(pa2, PKLH(l2, h2), od, 0, 0, 0);
  od = __builtin_amdgcn_mfma_f32_32x32x16_bf16(pa3, PKLH(l3, h3), od, 0, 0, 0);
}
template <int D0> __device__ __forceinline__ void pv_issue(s16x4 (&t)[8], int vb) {
  t[0] = tr_read<v_rd_off(D0, 0, 0)>(vb); t[1] = tr_read<v_rd_off(D0, 0, 1)>(vb); t[2] = tr_read<v_rd_off(D0, 1, 0)>(vb); t[3] = tr_read<v_rd_off(D0, 1, 1)>(vb);
  t[4] = tr_read<v_rd_off(D0, 2, 0)>(vb); t[5] = tr_read<v_rd_off(D0, 2, 1)>(vb); t[6] = tr_read<v_rd_off(D0, 3, 0)>(vb); t[7] = tr_read<v_rd_off(D0, 3, 1)>(vb);
}
__device__ __forceinline__ void pv_mma(f32x16& od, const s16x4 (&t)[8], bf16x8 pa0, bf16x8 pa1, bf16x8 pa2, bf16x8 pa3) {
  od = __builtin_amdgcn_mfma_f32_32x32x16_bf16(pa0, PKLH(t[0], t[1]), od, 0, 0, 0);
  od = __builtin_amdgcn_mfma_f32_32x32x16_bf16(pa1, PKLH(t[2], t[3]), od, 0, 0, 0);
  od = __builtin_amdgcn_mfma_f32_32x32x16_bf16(pa2, PKLH(t[4], t[5]), od, 0, 0, 0);
  od = __builtin_amdgcn_mfma_f32_32x32x16_bf16(pa3, PKLH(t[6], t[7]), od, 0, 0, 0);
}
__device__ __forceinline__ void pv_d0(f32x16* o, int vb, bf16x8 pa0, bf16x8 pa1, bf16x8 pa2, bf16x8 pa3) {
  s16x4 ta[8], tb[8];
  pv_issue<0>(ta, vb);
  pv_issue<1>(tb, vb); asm volatile("s_waitcnt lgkmcnt(8)" ::: "memory"); SBAR(); pv_mma(o[0], ta, pa0, pa1, pa2, pa3);
  pv_issue<2>(ta, vb); asm volatile("s_waitcnt lgkmcnt(8)" ::: "memory"); SBAR(); pv_mma(o[1], tb, pa0, pa1, pa2, pa3);
  pv_issue<3>(tb, vb); asm volatile("s_waitcnt lgkmcnt(8)" ::: "memory"); SBAR(); pv_mma(o[2], ta, pa0, pa1, pa2, pa3);
  asm volatile("s_waitcnt lgkmcnt(0)" ::: "memory"); SBAR(); pv_mma(o[3], tb, pa0, pa1, pa2, pa3);
}
#define PK4(P, BASE, OUT) do { unsigned a0 = cvt_pk(P[BASE + 0], P[BASE + 1]), a1 = cvt_pk(P[BASE + 2], P[BASE + 3]);   \
    unsigned b0 = cvt_pk(P[BASE + 4], P[BASE + 5]), b1 = cvt_pk(P[BASE + 6], P[BASE + 7]);                              \
    auto r0 = __builtin_amdgcn_permlane32_swap(a0, b0, false, false); auto r1 = __builtin_amdgcn_permlane32_swap(a1, b1, false, false); \
    u32x4 w = {r0[0], r1[0], r0[1], r1[1]}; OUT = *reinterpret_cast<bf16x8*>(&w); } while (0)

namespace att {
constexpr int DQK = 192, DV = 128, NW = 8, QBLK = 32, KVBLK = 64, NQD = DQK / 16;
constexpr int LDQ = 1536, LDK = 1536, LDV = 1024, LDO = 1024;
constexpr float SCALE = 0.07216878364870323f, THR = 8.f;
constexpr int SHM_V = KVBLK * DV * 2, SHM_K = KVBLK * DQK * 2;
#define KSWZ3(row, colB) ((row) * 384 + ((colB) ^ ((((row) >> 1) & 7) << 4)))
__device__ __forceinline__ void partialSM(f32x16& p0, f32x16& p1, float& m_reg, float& alpha, bool first) {
  constexpr float THR2 = THR * 1.4426950408889634f;
  float pmax = p0[0];
#pragma unroll
  for (int r = 1; r < 16; ++r) pmax = fmaxf(pmax, p0[r]);
#pragma unroll
  for (int r = 0; r < 16; ++r) pmax = fmaxf(pmax, p1[r]);
  { auto rr = __builtin_amdgcn_permlane32_swap(__float_as_uint(pmax), __float_as_uint(pmax), false, false);
    pmax = fmaxf(__uint_as_float(rr[0]), __uint_as_float(rr[1])); }
  if (__builtin_expect(!first && __all(pmax <= THR2), 1)) { alpha = 1.f; }
  else { const float d = first ? pmax : fmaxf(pmax, 0.f); alpha = __builtin_amdgcn_exp2f(-d); m_reg += d;
#pragma unroll
    for (int r = 0; r < 16; ++r) { p0[r] -= d; p1[r] -= d; } }
#pragma unroll
  for (int r = 0; r < 16; ++r) p0[r] = __builtin_amdgcn_exp2f(p0[r]);
}
__device__ __forceinline__ void finishSM(f32x16& p0, f32x16& p1, float alpha, float& l_reg, bf16x8& pa0, bf16x8& pa1, bf16x8& pa2, bf16x8& pa3) {
#pragma unroll
  for (int r = 0; r < 16; ++r) p1[r] = __builtin_amdgcn_exp2f(p1[r]);
  float ps = 0;
#pragma unroll
  for (int r = 0; r < 16; ++r) ps += p0[r];
#pragma unroll
  for (int r = 0; r < 16; ++r) ps += p1[r];
  { auto rr = __builtin_amdgcn_permlane32_swap(__float_as_uint(ps), __float_as_uint(ps), false, false);
    ps = __uint_as_float(rr[0]) + __uint_as_float(rr[1]); }
  l_reg = l_reg * alpha + ps;
  PK4(p0, 0, pa0); PK4(p0, 8, pa1); PK4(p1, 0, pa2); PK4(p1, 8, pa3);
}
__device__ __forceinline__ void qkt(f32x16& p0, f32x16& p1, const char* Ks, const bf16x8* qr, const char* qrl, int qsw, int r32, int hi, float init) {
#pragma unroll
  for (int r = 0; r < 16; ++r) { p0[r] = init; p1[r] = init; }
#pragma unroll
  for (int d0 = 0; d0 < 8; ++d0) { int cb = (d0 * 16 + hi * 8) * 2;
    bf16x8 b0 = *reinterpret_cast<const bf16x8*>(Ks + KSWZ3(r32, cb));
    bf16x8 b1 = *reinterpret_cast<const bf16x8*>(Ks + KSWZ3(32 + r32, cb));
    p0 = __builtin_amdgcn_mfma_f32_32x32x16_bf16(b0, qr[d0], p0, 0, 0, 0);
    p1 = __builtin_amdgcn_mfma_f32_32x32x16_bf16(b1, qr[d0], p1, 0, 0, 0); }
#pragma unroll
  for (int d0 = 0; d0 < 4; ++d0) { int cb = ((8 + d0) * 16 + hi * 8) * 2;
    bf16x8 q = *reinterpret_cast<const bf16x8*>(qrl + (((d0 * 2 + hi) ^ qsw) << 4));
    bf16x8 b0 = *reinterpret_cast<const bf16x8*>(Ks + KSWZ3(r32, cb));
    bf16x8 b1 = *reinterpret_cast<const bf16x8*>(Ks + KSWZ3(32 + r32, cb));
    p0 = __builtin_amdgcn_mfma_f32_32x32x16_bf16(b0, q, p0, 0, 0, 0);
    p1 = __builtin_amdgcn_mfma_f32_32x32x16_bf16(b1, q, p1, 0, 0, 0); }
}
__device__ __forceinline__ void attn_unit(const bf16_t* __restrict__ Qb, const bf16_t* __restrict__ Kh, const bf16_t* __restrict__ Vh, bf16_t* __restrict__ Ob, int seq, char* lds, LAS unsigned char* ldsl) {
  int tid_ = threadIdx.x; asm volatile("" : "+v"(tid_));
  const int tid = tid_, wid = __builtin_amdgcn_readfirstlane(tid >> 6), lane = tid & 63, r32 = lane & 31, hi = lane >> 5;
  constexpr int OFF_K = 3 * SHM_V, OFF_WS = 3 * SHM_V + 3 * SHM_K;
  char* V_lds = lds; char* K_lds = lds + OFF_K;
  float* ws = (float*)(lds + OFF_WS) + wid * 64; float* li_l = ws; float* al_l = ws + 32;
  float m_reg = 0.f, l_reg = 0; f32x16 o[4] = {}; bf16x8 qr[8];
  const bf16_t* Qw = Qb + (long)(wid * QBLK + r32) * LDQ + hi * 8;
#pragma unroll
  for (int d0 = 0; d0 < 8; ++d0) qr[d0] = *reinterpret_cast<const bf16x8*>(Qw + d0 * 16);
  char* qrl = lds + OFF_WS + 2048 + wid * 4096 + r32 * 128;
  const int qsw = (r32 >> 1) & 7;
#pragma unroll
  for (int d0 = 0; d0 < 4; ++d0) *(bf16x8*)(qrl + (((d0 * 2 + hi) ^ qsw) << 4)) = *reinterpret_cast<const bf16x8*>(Qw + 128 + d0 * 16);
  int kof[3], vof[2];
#pragma unroll
  for (int i = 0; i < 3; ++i) { const int L = (wid * 3 + i) * 1024 + lane * 16, row = L / 384, x = L - row * 384, cb = x ^ (((row >> 1) & 7) << 4); kof[i] = row * LDK + (cb >> 1); }
#pragma unroll
  for (int i = 0; i < 2; ++i) { const int L = (wid * 2 + i) * 1024 + lane * 16, sub = L >> 9, w = L & 511, kk = (sub >> 2) * 8 + (w >> 6), c = (sub & 3) * 32 + ((w & 63) >> 1);
    const int k = (kk & ~0xC) | ((kk & 4) << 1) | ((kk & 8) >> 1); vof[i] = k * LDV + c; }
  const int vb0 = (int)(uintptr_t)V_lds + v_rd_base(lane);
#define KVDMA(t, slot) do { const bf16_t* kb_ = Kh + (long)(t) * (KVBLK * LDK); const bf16_t* vb_ = Vh + (long)(t) * (KVBLK * LDV); \
    _Pragma("unroll") for (int i_ = 0; i_ < 3; ++i_) __builtin_amdgcn_global_load_lds((const unsigned*)(kb_ + kof[i_]), (LAS unsigned*)(ldsl + OFF_K + (slot) * SHM_K + (wid * 3 + i_) * 1024), 16, 0, 0); \
    _Pragma("unroll") for (int i_ = 0; i_ < 2; ++i_) __builtin_amdgcn_global_load_lds((const unsigned*)(vb_ + vof[i_]), (LAS unsigned*)(ldsl + (slot) * SHM_V + (wid * 2 + i_) * 1024), 16, 0, 0); } while (0)
#define TILE_SYNC() do { asm volatile("s_waitcnt vmcnt(0)" ::: "memory"); __syncthreads(); } while (0)
#define RESC(a) do { if (__any((a) < 1.f)) { if (hi == 0) al_l[r32] = (a); asm volatile("s_waitcnt lgkmcnt(0)" ::: "memory"); \
    _Pragma("unroll") for (int d = 0; d < 4; ++d) _Pragma("unroll") for (int r = 0; r < 16; ++r) o[d][r] *= al_l[crow(r, hi)]; } } while (0)
  f32x16 pA0, pA1, pB0, pB1; float alA, alB; bf16x8 pa0, pa1, pa2, pa3; const int NT = seq / KVBLK;
  KVDMA(0, 0); KVDMA(1, 1); TILE_SYNC();
  qkt(pA0, pA1, K_lds, qr, qrl, qsw, r32, hi, 0.f); partialSM(pA0, pA1, m_reg, alA, true);
  int sK = 1, sV = 0, sN = 2;
#define NEXT3(x) ((x) == 2 ? 0 : (x) + 1)
  for (int j = 1; j + 1 < NT; j += 2) {
    KVDMA(j + 1, sN);
    SBAR(); qkt(pB0, pB1, K_lds + sK * SHM_K, qr, qrl, qsw, r32, hi, -m_reg);
    finishSM(pA0, pA1, alA, l_reg, pa0, pa1, pa2, pa3); SBAR();
    pv_d0(o, vb0 + sV * SHM_V, pa0, pa1, pa2, pa3); partialSM(pB0, pB1, m_reg, alB, false);
    RESC(alB); TILE_SYNC();
    sV = sK; sK = sN; sN = NEXT3(sN);
    if (j + 2 < NT) KVDMA(j + 2, sN);
    SBAR(); qkt(pA0, pA1, K_lds + sK * SHM_K, qr, qrl, qsw, r32, hi, -m_reg);
    finishSM(pB0, pB1, alB, l_reg, pa0, pa1, pa2, pa3); SBAR();
    pv_d0(o, vb0 + sV * SHM_V, pa0, pa1, pa2, pa3); partialSM(pA0, pA1, m_reg, alA, false);
    RESC(alA); TILE_SYNC();
    sV = sK; sK = sN; sN = NEXT3(sN);
  }
  SBAR(); qkt(pB0, pB1, K_lds + sK * SHM_K, qr, qrl, qsw, r32, hi, -m_reg);
  finishSM(pA0, pA1, alA, l_reg, pa0, pa1, pa2, pa3); SBAR();
  pv_d0(o, vb0 + sV * SHM_V, pa0, pa1, pa2, pa3); partialSM(pB0, pB1, m_reg, alB, false);
  RESC(alB);
  finishSM(pB0, pB1, alB, l_reg, pa0, pa1, pa2, pa3); SBAR();
  pv_d0(o, vb0 + sK * SHM_V, pa0, pa1, pa2, pa3);
  if (hi == 0) li_l[r32] = l_reg; asm volatile("s_waitcnt lgkmcnt(0)" ::: "memory");
  float rli[16];
#pragma unroll
  for (int r = 0; r < 16; ++r) rli[r] = __builtin_amdgcn_rcpf(li_l[crow(r, hi)]);
  bf16_t* Ow = Ob + (long)(wid * QBLK) * LDO;
#pragma unroll
  for (int r = 0; r < 16; ++r) { int orow = crow(r, hi);
#pragma unroll
    for (int d0 = 0; d0 < 4; ++d0) Ow[(long)orow * LDO + d0 * 32 + r32] = (bf16_t)(cvt_pk(o[d0][r] * rli[r], 0.f) & 0xffffu); }
  __syncthreads();
#undef KVDMA
#undef TILE_SYNC
#undef RESC
#undef NEXT3
}
}

#define KSWZ(row, colB) ((row) * 256 + ((colB) ^ ((((row) & 7) << 4) | ((((row) >> 3) & 1) << 7))))
__device__ __forceinline__ bf16x8 scale8(bf16x8 x, float s) {
  u32x4 w = *reinterpret_cast<u32x4*>(&x);
  u32x4 o = {cvt_pk(bflo(w.x) * s, bfhi(w.x) * s), cvt_pk(bflo(w.y) * s, bfhi(w.y) * s), cvt_pk(bflo(w.z) * s, bfhi(w.z) * s), cvt_pk(bflo(w.w) * s, bfhi(w.w) * s)};
  return *reinterpret_cast<bf16x8*>(&o);
}
__device__ __forceinline__ void stage_v_chunk(const bf16_t* Vg, char* lds, int tid) {
#pragma unroll
  for (int i = 0; i < 8; ++i) { const int p = tid + 512 * i, row = p >> 5, col = (p & 31) * 8;
    const bf16x8 v = *reinterpret_cast<const bf16x8*>(Vg + (size_t)row * 1024 + col);
    *(bf16x8*)(lds + ((row >> 6) * 2 + (col >> 7)) * 16384 + v_st(row & 63, col & 127)) = v; }
}
template <int OFF> __device__ __forceinline__ bf16x8 tr_frag(int base) { const s16x4 l = tr_read<OFF>(base), h = tr_read<OFF + 2048>(base); asm volatile("s_waitcnt lgkmcnt(0)" ::: "memory"); return PKLH(l, h); }

__device__ __forceinline__ void ret_kv_item(const Bufs& b, int item, float lgf2, float lgb2, char* lds) {
  int tid_ = threadIdx.x; asm volatile("" : "+v"(tid_));
  const int tid = tid_, wid = tid >> 6, lane = tid & 63, r32 = lane & 31, hi = lane >> 5;
  const int ci = item >> 2, h = item & 3; const size_t tok0 = (size_t)ci * 128;
  const bf16_t* Kg = b.RK + tok0 * 512 + h * 128; const bf16_t* Vg = b.RV + tok0 * 1024 + h * 256;
  stage_v_chunk(Vg, lds, tid);
#pragma unroll
  for (int i = 0; i < 4; ++i) { const int p = tid + 512 * i, row = p >> 4, col = (p & 15) * 8;
    const bf16x8 k = *reinterpret_cast<const bf16x8*>(Kg + (size_t)row * 512 + col);
    const float sf = __builtin_amdgcn_exp2f(lgf2 * (float)(127 - row)), sb = __builtin_amdgcn_exp2f(lgb2 * (float)row);
    const int off = (row >> 6) * 16384 + v_st(row & 63, col);
    *(bf16x8*)(lds + 65536 + off) = scale8(k, sf); *(bf16x8*)(lds + 98304 + off) = scale8(k, sb); }
  __syncthreads();
  const int rb = v_rd_base(lane), lb = (int)(uintptr_t)lds;
  const int vbase = lb + (wid >> 2) * 16384 + rb + (wid & 3) * 512;
#define R1_STEP(T, KS, KOFF) do { const bf16x8 a = tr_frag<v_rd_off(0, KS, 0)>(vbase + (T) * 32768); \
    { const int kf = lb + (KOFF) + (T) * 16384 + rb; \
      const bf16x8 f0 = tr_frag<v_rd_off(0, KS, 0)>(kf), f1 = tr_frag<v_rd_off(1, KS, 0)>(kf), f2 = tr_frag<v_rd_off(2, KS, 0)>(kf), f3 = tr_frag<v_rd_off(3, KS, 0)>(kf); \
      aF[0] = __builtin_amdgcn_mfma_f32_32x32x16_bf16(a, f0, aF[0], 0, 0, 0); aF[1] = __builtin_amdgcn_mfma_f32_32x32x16_bf16(a, f1, aF[1], 0, 0, 0); \
      aF[2] = __builtin_amdgcn_mfma_f32_32x32x16_bf16(a, f2, aF[2], 0, 0, 0); aF[3] = __builtin_amdgcn_mfma_f32_32x32x16_bf16(a, f3, aF[3], 0, 0, 0); } SBAR(); } while (0)
#pragma unroll
  for (int dir = 0; dir < 2; ++dir) {
    f32x16 aF[4] = {};
    if (dir == 0) { R1_STEP(0, 0, 65536); R1_STEP(0, 1, 65536); R1_STEP(0, 2, 65536); R1_STEP(0, 3, 65536); R1_STEP(1, 0, 65536); R1_STEP(1, 1, 65536); R1_STEP(1, 2, 65536); R1_STEP(1, 3, 65536); }
    else { R1_STEP(0, 0, 98304); R1_STEP(0, 1, 98304); R1_STEP(0, 2, 98304); R1_STEP(0, 3, 98304); R1_STEP(1, 0, 98304); R1_STEP(1, 1, 98304); R1_STEP(1, 2, 98304); R1_STEP(1, 3, 98304); }
    bf16_t* od = b.KV + (size_t)item * 65536 + dir * 32768;
#pragma unroll
    for (int n0 = 0; n0 < 4; ++n0)
#pragma unroll
      for (int r = 0; r < 16; ++r) od[(32 * wid + crow(r, hi)) * 128 + 32 * n0 + r32] = (bf16_t)(cvt_pk_s(aF[n0][r], 0.f) & 0xffffu);
    SBAR();
  }
#undef R1_STEP
  __syncthreads();
}

__device__ __forceinline__ float lg2_of(const float* dec, int h);
__device__ __forceinline__ void ret_scan(const Bufs& b, int nseq, int NC, const float* dec_f, const float* dec_b, int gtid, int gthreads) {
  const int nvec = nseq * 32768;
  for (int v = gtid; v < nvec; v += gthreads) {
    const int e8 = v & 4095, dir = (v >> 12) & 1, h = (v >> 13) & 3, s = v >> 15;
    const float decay = __builtin_amdgcn_exp2f(lg2_of(dir ? dec_b : dec_f, h) * 128.f);
    float st[8];
#pragma unroll
    for (int e = 0; e < 8; ++e) st[e] = 0.f;
    for (int step = 0; step < NC; step += 4) {
      u32x4 kv[4]; bf16_t* ptr[4];
#pragma unroll
      for (int q = 0; q < 4; ++q) { const int c = dir ? NC - 1 - (step + q) : step + q; ptr[q] = b.KV + ((size_t)(((s * NC + c) * 4 + h) * 2 + dir)) * 32768 + e8 * 8; kv[q] = *(const u32x4*)ptr[q]; }
#pragma unroll
      for (int q = 0; q < 4; ++q) {
        u32x4 o = {cvt_pk(st[0], st[1]), cvt_pk(st[2], st[3]), cvt_pk(st[4], st[5]), cvt_pk(st[6], st[7])}; *(u32x4*)ptr[q] = o;
        st[0] = st[0] * decay + bflo(kv[q].x); st[1] = st[1] * decay + bfhi(kv[q].x); st[2] = st[2] * decay + bflo(kv[q].y); st[3] = st[3] * decay + bfhi(kv[q].y);
        st[4] = st[4] * decay + bflo(kv[q].z); st[5] = st[5] * decay + bfhi(kv[q].z); st[6] = st[6] * decay + bflo(kv[q].w); st[7] = st[7] * decay + bfhi(kv[q].w); }
    }
  }
}

__device__ __forceinline__ void qkt128(f32x16& p0, f32x16& p1, const char* Ks, const bf16x8* qr, int r32, int hi) {
  p0 = f32x16{}; p1 = f32x16{};
#pragma unroll
  for (int d0 = 0; d0 < 8; ++d0) { int cb = (d0 * 16 + hi * 8) * 2;
    bf16x8 b0 = *reinterpret_cast<const bf16x8*>(Ks + KSWZ(r32, cb));
    bf16x8 b1 = *reinterpret_cast<const bf16x8*>(Ks + KSWZ(32 + r32, cb));
    p0 = __builtin_amdgcn_mfma_f32_32x32x16_bf16(b0, qr[d0], p0, 0, 0, 0);
    p1 = __builtin_amdgcn_mfma_f32_32x32x16_bf16(b1, qr[d0], p1, 0, 0, 0); }
}
__device__ __forceinline__ void ret_out_item(const Bufs& b, int item, float lgf2, float lgb2, const float* gn_g, char* lds) {
  int tid_ = threadIdx.x; asm volatile("" : "+v"(tid_));
  const int tid = tid_, wid = tid >> 6, lane = tid & 63, r32 = lane & 31, hi = lane >> 5, wr = wid & 3, wc = wid >> 2;
  const int ci = item >> 2, h = item & 3; const size_t tok0 = (size_t)ci * 128;
  const bf16_t* Qg = b.RQ + tok0 * 512 + h * 128; const bf16_t* Kg = b.RK + tok0 * 512 + h * 128; const bf16_t* Vg = b.RV + tok0 * 1024 + h * 256;
  const bf16_t* Sf = b.KV + (size_t)item * 65536; const bf16_t* Sb = Sf + 32768;
  char* K_lds = lds; char* V_lds = lds + 32768;
#pragma unroll
  for (int i = 0; i < 4; ++i) { const int p = tid + 512 * i, row = p >> 4, col = (p & 15) * 8;
    *(bf16x8*)(K_lds + KSWZ(row, col * 2)) = *reinterpret_cast<const bf16x8*>(Kg + (size_t)row * 512 + col); }
  stage_v_chunk(Vg, V_lds, tid);
  bf16x8 qr[8];
  { const bf16_t* Qw = Qg + (size_t)(wr * 32 + r32) * 512 + hi * 8;
#pragma unroll
    for (int d0 = 0; d0 < 8; ++d0) qr[d0] = *reinterpret_cast<const bf16x8*>(Qw + d0 * 16); }
  __syncthreads();
  f32x16 o[4] = {};
  const int irow = wr * 32 + r32;
#pragma unroll
  for (int t = 0; t < 2; ++t) {
    f32x16 p0, p1; qkt128(p0, p1, K_lds + t * 16384, qr, r32, hi);
#pragma unroll
    for (int r = 0; r < 16; ++r) { const int j0 = 64 * t + crow(r, hi), d0_ = irow - j0, d1_ = d0_ - 32;
      p0[r] *= __builtin_amdgcn_exp2f(d0_ >= 0 ? lgf2 * (float)d0_ : lgb2 * (float)(-d0_));
      p1[r] *= __builtin_amdgcn_exp2f(d1_ >= 0 ? lgf2 * (float)d1_ : lgb2 * (float)(-d1_)); }
    bf16x8 pa0, pa1, pa2, pa3; PK4(p0, 0, pa0); PK4(p0, 8, pa1); PK4(p1, 0, pa2); PK4(p1, 8, pa3);
    pv_d0(o, (int)(uintptr_t)V_lds + (t * 2 + wc) * 16384 + v_rd_base(lane), pa0, pa1, pa2, pa3);
    SBAR();
  }
  bf16x8 sfv[8], sbv[8];
#pragma unroll
  for (int i = 0; i < 8; ++i) { const int p = tid + 512 * i, row = p >> 4, col = (p & 15) * 8;
    sfv[i] = *reinterpret_cast<const bf16x8*>(Sf + (size_t)row * 128 + col); sbv[i] = *reinterpret_cast<const bf16x8*>(Sb + (size_t)row * 128 + col); }
  __syncthreads();
#pragma unroll
  for (int i = 0; i < 8; ++i) { const int p = tid + 512 * i, row = p >> 4, col = (p & 15) * 8;
    *(bf16x8*)(lds + KSWZ(row, col * 2)) = sfv[i]; *(bf16x8*)(lds + 65536 + KSWZ(row, col * 2)) = sbv[i]; }
  const float qdf = __builtin_amdgcn_exp2f(lgf2 * (float)(irow + 1)), qdb = __builtin_amdgcn_exp2f(lgb2 * (float)(128 - irow));
  __syncthreads();
#pragma unroll
  for (int s = 0; s < 8; ++s) { const bf16x8 af = scale8(qr[s], qdf), ab = scale8(qr[s], qdb); const int cb = (s * 16 + hi * 8) * 2;
#pragma unroll
    for (int d = 0; d < 4; ++d) { const int srow = 128 * wc + 32 * d + r32;
      const bf16x8 bf = *reinterpret_cast<const bf16x8*>(lds + KSWZ(srow, cb)), bb = *reinterpret_cast<const bf16x8*>(lds + 65536 + KSWZ(srow, cb));
      o[d] = __builtin_amdgcn_mfma_f32_32x32x16_bf16(af, bf, o[d], 0, 0, 0);
      o[d] = __builtin_amdgcn_mfma_f32_32x32x16_bf16(ab, bb, o[d], 0, 0, 0); }
    SBAR(); }
  const int nrow = tid >> 2, nq = tid & 3; const size_t gofs = (tok0 + nrow) * 1024 + h * 256 + nq * 8; u32x4 rgv[8];
#pragma unroll
  for (int k = 0; k < 8; ++k) rgv[k] = *(const u32x4*)(b.RG + gofs + 32 * k);
  __syncthreads();
  float* ol = (float*)lds;
#pragma unroll
  for (int d = 0; d < 4; ++d)
#pragma unroll
    for (int r = 0; r < 16; ++r) ol[(wr * 32 + crow(r, hi)) * 260 + wc * 128 + d * 32 + r32] = o[d][r];
  __syncthreads();
  { const int row = nrow, q = nq; const float* rp = ol + row * 260 + q * 8;
    f32x4 x[16]; float s = 0.f;
#pragma unroll
    for (int k = 0; k < 8; ++k) { x[2 * k] = *(const f32x4*)(rp + 32 * k); x[2 * k + 1] = *(const f32x4*)(rp + 32 * k + 4); s += (x[2 * k][0] + x[2 * k][1]) + (x[2 * k][2] + x[2 * k][3]) + (x[2 * k + 1][0] + x[2 * k + 1][1]) + (x[2 * k + 1][2] + x[2 * k + 1][3]); }
    s += __shfl_xor(s, 1); s += __shfl_xor(s, 2); const float mu = s * (1.f / 256.f); float v = 0.f;
#pragma unroll
    for (int k = 0; k < 16; ++k) { x[k] = x[k] - mu; v += dot4(x[k]); }
    v += __shfl_xor(v, 1); v += __shfl_xor(v, 2); const float rstd = rsqrtf(v * (1.f / 256.f) + EPS);
    const float* gp = gn_g + h * 256 + q * 8;
#pragma unroll
    for (int k = 0; k < 8; ++k) { const u32x4 rw = rgv[k]; const f32x4 ga = {bflo(rw.x), bfhi(rw.x), bflo(rw.y), bfhi(rw.y)}, gb = {bflo(rw.z), bfhi(rw.z), bflo(rw.w), bfhi(rw.w)}; const f32x4 w0 = *(const f32x4*)(gp + 32 * k), w1 = *(const f32x4*)(gp + 32 * k + 4);
      st8(b.URET + gofs + 32 * k, x[2 * k] * rstd * w0 * ga, x[2 * k + 1] * rstd * w1 * gb); } }
  __syncthreads();
}

__device__ __forceinline__ int src_col(int mat, int n) {
  if (mat == 0) {
    if (n < 1024) { const int base = n & ~127, hc = n & 127; return base + ((hc & 1) ? (hc >> 1) + 64 : (hc >> 1)); }
    if (n < 3072) return n;
    if (n < 4096) return 3776 + (n - 3072);
    if (n < 5120) return 4800 + (n - 4096);
    if (n < 5504) return 3072 + (n - 5120);
    if (n < 5568) { const int kc = n - 5504; return 3712 + ((kc & 1) ? (kc >> 1) + 32 : (kc >> 1)); }
    if (n < 5632) return -1;
    return 3456 + (n - 5632);
  }
  if (mat == 1) { const int head = n >> 8, hc = n & 255; if (hc < 128) return head * 192 + hc; if (hc < 192) { const int kc = hc - 128; return head * 192 + 128 + ((kc & 1) ? (kc >> 1) + 32 : (kc >> 1)); } return -1; }
  return n;
}
__device__ __forceinline__ void prep_tile(const float* W, int K, int Nsrc, const float* gain, bf16_t* Bt, int mat, int n0, int k0, float* scr, int tid) {
  const int tx = tid & 63, ty = tid >> 6; const int src = src_col(mat, n0 + tx);
#pragma unroll
  for (int kk = ty; kk < 64; kk += 8) { float v = 0.f; if (src >= 0) { v = W[(size_t)(k0 + kk) * Nsrc + src]; if (gain) v *= gain[k0 + kk]; } scr[kk * 65 + tx] = v; }
  __syncthreads();
  { const int n = tid >> 3, kq = (tid & 7) * 8; const float* s = scr + kq * 65 + n;
    u32x4 o = {cvt_pk(s[0], s[65]), cvt_pk(s[130], s[195]), cvt_pk(s[260], s[325]), cvt_pk(s[390], s[455])};
    *(u32x4*)(Bt + (size_t)(n0 + n) * K + k0 + kq) = o; }
  __syncthreads();
}
__device__ __forceinline__ void h1_rows(const Bufs& b, const float* gmix, int CH, int gw, int ngw_, int lane_) {
  int lane = lane_; asm volatile("" : "+v"(lane)); int ngw = ngw_; asm volatile("" : "+s"(ngw));
  for (int r = gw * 4; r < CH; r += ngw * 4) {
    f32x4 v[4][4]; float s[4];
#pragma unroll
    for (int q = 0; q < 4; ++q) { const f32x4* xq = (const f32x4*)xrow(b, b.g0 + r + q) + lane;
#pragma unroll
      for (int j = 0; j < 4; ++j) v[q][j] = xq[64 * j]; }
#pragma unroll
    for (int q = 0; q < 4; ++q) { s[q] = 0.f;
#pragma unroll
      for (int j = 0; j < 4; ++j) s[q] += dot4(v[q][j]); }
#pragma unroll
    for (int o = 1; o < 64; o <<= 1) {
#pragma unroll
      for (int q = 0; q < 4; ++q) s[q] += __shfl_xor(s[q], o); }
#pragma unroll
    for (int q = 0; q < 4; ++q) { const float rs = rsqrtf(s[q] * (1.f / 1024.f) + EPS); u32x2* oq = (u32x2*)(b.H1O + (size_t)(r + q) * 1024) + lane;
#pragma unroll
      for (int j = 0; j < 4; ++j) { const f32x4 g = ((const f32x4*)gmix)[lane + 64 * j]; const f32x4 y = v[q][j] * rs * g; u32x2 w = {cvt_pk(y[0], y[1]), cvt_pk(y[2], y[3])}; oq[64 * j] = w; } } }
}
__device__ __forceinline__ void conv_gate(const Bufs& b, const float* cw, const float* cbias, int CH, int bid, int nb, int tid) {
  if (tid >= 352) return;
  const int c = tid * 8;
  float w[2][3][8], bs[2][8];
#pragma unroll
  for (int hf = 0; hf < 2; ++hf) {
#pragma unroll
    for (int k = 0; k < 3; ++k) { const f32x4 a = *(const f32x4*)(cw + (size_t)k * N_UP + hf * DFF + c), d = *(const f32x4*)(cw + (size_t)k * N_UP + hf * DFF + c + 4);
#pragma unroll
      for (int e = 0; e < 4; ++e) { w[hf][k][e] = a[e]; w[hf][k][4 + e] = d[e]; } }
    const f32x4 a = *(const f32x4*)(cbias + hf * DFF + c), d = *(const f32x4*)(cbias + hf * DFF + c + 4);
#pragma unroll
    for (int e = 0; e < 4; ++e) { bs[hf][e] = a[e]; bs[hf][4 + e] = d[e]; } }
  for (int strip = bid; strip < CH / 8; strip += nb) {
    const int r0 = strip * 8; const int pos0 = (b.g0 + r0) & b.slm;
    u32x4 raw[2][10];
    const bool hp = pos0 > 0, hn = (pos0 + 8) <= b.slm;
#pragma unroll
    for (int hf = 0; hf < 2; ++hf) {
      const bf16_t* base = b.UR + (size_t)r0 * N_UP + hf * DFF + c;
      raw[hf][0] = hp ? *(const u32x4*)(base - N_UP) : (u32x4){0u, 0u, 0u, 0u};
#pragma unroll
      for (int i = 0; i < 8; ++i) raw[hf][1 + i] = *(const u32x4*)(base + (size_t)i * N_UP);
      raw[hf][9] = hn ? *(const u32x4*)(base + (size_t)8 * N_UP) : (u32x4){0u, 0u, 0u, 0u};
    }
#pragma unroll
    for (int i = 0; i < 8; ++i) {
      float ua[8], ub[8];
#pragma unroll
      for (int e = 0; e < 8; ++e) { ua[e] = bs[0][e]; ub[e] = bs[1][e]; }
#pragma unroll
      for (int k = 0; k < 3; ++k) { const u32x4 xa = raw[0][i + k], xb = raw[1][i + k];
        const float fa[8] = {bflo(xa.x), bfhi(xa.x), bflo(xa.y), bfhi(xa.y), bflo(xa.z), bfhi(xa.z), bflo(xa.w), bfhi(xa.w)};
        const float fb[8] = {bflo(xb.x), bfhi(xb.x), bflo(xb.y), bfhi(xb.y), bflo(xb.z), bfhi(xb.z), bflo(xb.w), bfhi(xb.w)};
#pragma unroll
        for (int e = 0; e < 8; ++e) { ua[e] += fa[e] * w[0][k][e]; ub[e] += fb[e] * w[1][k][e]; } }
      f32x4 y0, y1;
#pragma unroll
      for (int e = 0; e < 4; ++e) { y0[e] = ua[e] * sigm(ua[e]) * ub[e]; y1[e] = ua[4 + e] * sigm(ua[4 + e]) * ub[4 + e]; }
      st8(b.G + (size_t)(r0 + i) * DFF + c, y0, y1);
    }
  }
}


#define XB_TMO      128
#define XB_XCNT(j)  (256  + 64 * (j))
#define XB_XSUB(j)  (1280 + 64 * (j))
#define XB_XGEN(j)  (2304 + 64 * (j))
#define XB_TOP      3328
#define XB_TOPGEN   3392
#define XCD_BAR_WORDS 3456
#define XB_SPIN_CAP (1u << 18)
__device__ __forceinline__ unsigned xb_ld(unsigned* p)              { return __hip_atomic_load(p, __ATOMIC_RELAXED, __HIP_MEMORY_SCOPE_AGENT); }
__device__ __forceinline__ unsigned xb_add(unsigned* p, unsigned v) { return __hip_atomic_fetch_add(p, v, __ATOMIC_RELAXED, __HIP_MEMORY_SCOPE_AGENT); }
__device__ __forceinline__ unsigned xb_xcc_id() { return (unsigned)__builtin_amdgcn_s_getreg((3 << 11) | 20) & 0xFu; }
#define XB_SPIN(cond, bar) do { unsigned _sp = 0; while (cond) { __builtin_amdgcn_s_sleep(1); \
    if ((++_sp & 255u) == 0u) { if (xb_ld(&(bar)[XB_TMO])) break; if (_sp > XB_SPIN_CAP) { atomicAdd(&(bar)[XB_TMO], 1u); break; } } } } while (0)
struct XcdBarrier { unsigned* bar; unsigned x; volatile LAS unsigned* st; };
__device__ __forceinline__ XcdBarrier xcd_barrier_post(unsigned* bar, volatile LAS unsigned* st) {
  XcdBarrier b; b.bar = bar; b.x = xb_xcc_id(); b.st = st;
  if (threadIdx.x == 0) (void)xb_add(&bar[XB_XCNT(b.x)], 1u);
  return b;
}
__device__ __forceinline__ void xcd_barrier_complete(unsigned* bar, unsigned x, unsigned& nloc, unsigned& nx) {
  const unsigned G = gridDim.x * gridDim.y * gridDim.z;
  unsigned sum, cnt, mine, sp = 0u;
  for (;;) {
    sum = 0u; cnt = 0u; mine = 0u;
#pragma unroll
    for (unsigned j = 0; j < 16; ++j) { const unsigned c = xb_ld(&bar[XB_XCNT(j)]); sum += c; cnt += (c > 0u) ? 1u : 0u; mine = (j == x) ? c : mine; }
    if (sum == G) break;
    __builtin_amdgcn_s_sleep(1);
    if ((++sp & 255u) == 0u) { if (xb_ld(&bar[XB_TMO])) break; if (sp > XB_SPIN_CAP) { atomicAdd(&bar[XB_TMO], 1u); break; } }
  }
  nloc = mine > 0u ? mine : 1u; nx = cnt > 0u ? cnt : 1u;
}
__device__ __forceinline__ void xcd_barrier(const XcdBarrier& b) {
  asm volatile("s_waitcnt vmcnt(0)" ::: "memory");
  __syncthreads();
  if (threadIdx.x == 0) {
    unsigned* bar = b.bar;
    __builtin_amdgcn_s_waitcnt(0);
    unsigned nloc = b.st[0], nx = b.st[1];
    if (nloc == 0u) { xcd_barrier_complete(bar, b.x, nloc, nx); b.st[0] = nloc; b.st[1] = nx; }
    const unsigned old = xb_add(&bar[XB_XSUB(b.x)], 1u);
    const unsigned gen = old / nloc;
    if (old + 1u == (gen + 1u) * nloc) {
      __builtin_amdgcn_fence(__ATOMIC_RELEASE, "agent");
      asm volatile("s_waitcnt vmcnt(0)" ::: "memory");
      const unsigned og = xb_add(&bar[XB_TOP], 1u);
      const unsigned tg = og / nx;
      if (og + 1u == (tg + 1u) * nx) xb_add(&bar[XB_TOPGEN], 1u);
      else XB_SPIN(xb_ld(&bar[XB_TOPGEN]) == tg, bar);
      __builtin_amdgcn_fence(__ATOMIC_ACQUIRE, "agent");
      xb_add(&bar[XB_XGEN(b.x)], 1u);
      asm volatile("s_waitcnt vmcnt(0)" ::: "memory");
    } else {
      XB_SPIN(xb_ld(&bar[XB_XGEN(b.x)]) == gen, bar);
      __builtin_amdgcn_fence(__ATOMIC_ACQUIRE, "agent");
      asm volatile("s_waitcnt vmcnt(0)" ::: "memory");
    }
  }
  __syncthreads();
}

typedef const __attribute__((address_space(4))) Args* KArgsP;
__device__ __forceinline__ KArgsP kargs() { KArgsP p = (KArgsP)__builtin_amdgcn_kernarg_segment_ptr(); asm volatile("" : "+s"(p)); return p; }
template <int CHT> __device__ __forceinline__ Bufs make_bufs(KArgsP ap, int chunk) {
  Bufs b; unsigned char* ws = ap->ws; asm volatile("" : "+s"(ws)); unsigned char* cb = ws + WS_PERM_END; constexpr size_t CH = (size_t)CHT;
  b.H1O = (bf16_t*)(cb + PT_H1O * CH); b.RG = (bf16_t*)(cb + PT_RG * CH); b.RQ = (bf16_t*)(cb + PT_RQ * CH); b.RK = (bf16_t*)(cb + PT_RK * CH); b.RV = (bf16_t*)(cb + PT_RV * CH);
  b.GR = (bf16_t*)(cb + PT_GR * CH); b.GA = (bf16_t*)(cb + PT_GA * CH); b.CQ = (bf16_t*)(cb + PT_CQ * CH); b.CKV = (bf16_t*)(cb + PT_CKV * CH); b.KR = (bf16_t*)(cb + PT_KR * CH);
  b.Q = (bf16_t*)(cb + PT_Q * CH); b.K = (bf16_t*)(cb + PT_K * CH); b.V = (bf16_t*)(cb + PT_V * CH); b.URET = (bf16_t*)(cb + PT_URET * CH); b.KV = (bf16_t*)(cb + PT_KV * CH);
  b.UR = (bf16_t*)(cb + PT_UR * CH); b.G = (bf16_t*)(cb + PT_G * CH);
  b.rope = (const float*)(ws + WS_ROPE); float* sq = (float*)(ws + WS_SSQ); b.ssq_cq = sq; b.ssq_ckv = sq + 8 * (size_t)TT; b.ssq_kr = sq + 12 * (size_t)TT; b.ssq_x1 = sq + 14 * (size_t)TT;
  b.gqp = (const float*)(ws + WS_GP); b.gkp = b.gqp + 256;
  b.xp = ap->in[0]; b.xs = ap->in[1]; b.out = ap->out; b.g0 = chunk * CHT; b.slm = (b.g0 < NP) ? 4095 : 8191;
  return b;
}

__device__ __forceinline__ float lg2_of(const float* dec, int h) { return -log1pf(__expf(-dec[h])) * 1.4426950408889634f; }
template <int CH>
__global__ void __launch_bounds__(512, 2) fwd_kernel(Args a) {
  extern __shared__ __attribute__((aligned(16))) unsigned char lds_raw[];
  LAS unsigned char* lds = (LAS unsigned char*)lds_raw;
  char* ldsg = (char*)lds_raw;
  const int bid = blockIdx.x, G = gridDim.x;
  constexpr int nchunk = TT / CH;
  volatile LAS unsigned* bst = (volatile LAS unsigned*)(lds + LDS_BYTES - 16);
  if (threadIdx.x == 0) { bst[0] = 0u; bst[1] = 0u; }
  __syncthreads();
  XcdBarrier xbar; xbar.bar = nullptr; xbar.x = 0; xbar.st = bst;
#define PHASE_BEGIN(do_it) { for (int rs_ = 0; rs_ < DUP_SYNC; ++rs_) { XcdBarrier xb_ = xbar; xb_.bar = (unsigned*)(kargs()->ws + WS_BAR); xcd_barrier(xb_); } do_it = true; }
#define TIDS int tid = threadIdx.x; asm volatile("" : "+v"(tid)); const int lane = tid & 63, wid = tid >> 6; (void)lane; (void)wid
#define WSL unsigned char* ws = kargs()->ws; asm volatile("" : "+s"(ws))
#define WT(off) ((bf16_t*)(ws + (off)))
  bool run;
  run = true;
  if (run && PM(0)) for (int rep_ = 0; rep_ < DUP_P0; ++rep_) {
    TIDS; WSL; const int gtid = bid * 512 + tid, gthreads = G * 512;
    {
      const int T0 = 92 * 16, T1 = T0 + 32 * 6, T2 = T1 + 32 * 4, T3 = T2 + 256, T4 = T3 + 256, T5 = T4 + 256, T6 = T5 + 88 * 16, T7 = T6 + 16 * 44;
      for (int t = bid; t < T7; t += G) {
        if (t < T0) { prep_tile(kargs()->in[3], 1024, 5824, nullptr, WT(WS_WIN), 0, (t / 16) * 64, (t % 16) * 64, (float*)ldsg, tid); }
        else if (t < T1) { const int q = t - T0; prep_tile(kargs()->in[9], 384, 1536, kargs()->in[8], WT(WS_WUQ), 1, (q / 6) * 64, (q % 6) * 64, (float*)ldsg, tid); }
        else if (t < T2) { const int q = t - T1; prep_tile(kargs()->in[11], 256, 2048, kargs()->in[10], WT(WS_WUKV), 2, (q / 4) * 64, (q % 4) * 64, (float*)ldsg, tid); }
        else if (t < T3) { const int q = t - T2; prep_tile(kargs()->in[7], 1024, 1024, nullptr, WT(WS_WRO), 2, (q / 16) * 64, (q % 16) * 64, (float*)ldsg, tid); }
        else if (t < T4) { const int q = t - T3; prep_tile(kargs()->in[14], 1024, 1024, nullptr, WT(WS_WMO), 2, (q / 16) * 64, (q % 16) * 64, (float*)ldsg, tid); }
        else if (t < T5) { const int q = t - T4; prep_tile(kargs()->in[15], 1024, 1024, nullptr, WT(WS_WOUT), 2, (q / 16) * 64, (q % 16) * 64, (float*)ldsg, tid); }
        else if (t < T6) { const int q = t - T5; prep_tile(kargs()->in[17], 1024, N_UP, kargs()->in[16], WT(WS_WUP), 2, (q / 16) * 64, (q % 16) * 64, (float*)ldsg, tid); }
        else { const int q = t - T6; prep_tile(kargs()->in[20], DFF, 1024, nullptr, WT(WS_WDN), 2, (q / 44) * 64, (q % 44) * 64, (float*)ldsg, tid); }
      }
    }
    { float* rope = (float*)(ws + WS_ROPE);
      for (int i = gtid; i < 8192 * 64; i += gthreads) { const int pos = i >> 6, fi = i & 63;
        const double inv = exp2(-(double)fi * (13.287712379549449 / 64.0)); double rev = (double)pos * inv * 0.15915494309189535; rev -= floor(rev);
        const float rf = (float)rev; rope[2 * i] = __builtin_amdgcn_cosf(rf); rope[2 * i + 1] = __builtin_amdgcn_sinf(rf); } }
    if (bid == 0) { unsigned* bw = (unsigned*)(ws + WS_BAR); for (int i = tid; i < 4096; i += 512) bw[i] = 0u; }
    if (bid == 0 && tid < 256) { float* gp = (float*)(ws + WS_GP); const int c = tid; const float *g_qn = kargs()->in[12], *g_kn = kargs()->in[13];
      float q, k; if (c < 128) { q = g_qn[c]; k = g_kn[c]; } else if (c < 192) { const int kc = c - 128, d = (kc & 1) ? (kc >> 1) + 32 : (kc >> 1); q = g_qn[128 + d]; k = g_kn[128 + d]; } else { q = 0.f; k = 0.f; }
      gp[c] = q; gp[256 + c] = k; }
    { const Bufs b = make_bufs<CH>(kargs(), 0); h1_rows(b, kargs()->in[2], CH, bid * 8 + wid, G * 8, lane); }
  }
  cg::this_grid().sync();
  { XcdBarrier p_ = xcd_barrier_post((unsigned*)(kargs()->ws + WS_BAR), bst); xbar.x = p_.x; }
  for (int chunk = 0; chunk < nchunk; ++chunk) {
    const int SL = (chunk * CH < NP) ? 4096 : 8192, nseq = CH / SL, NC = SL / 128;
#define MKB const Bufs b = make_bufs<CH>(kargs(), chunk)
    PHASE_BEGIN(run);
    if (run && PM(1)) for (int rep_ = 0; rep_ < DUP_P1; ++rep_) { MKB; WSL; pg8::Gemm g{b.H1O, WT(WS_WIN), CH, N_IN, 1024, 1024}; pg8::StaticOrder S; S.init(CH, N_IN, G, bid); EpiIn E{b, rep_ == 0}; pg8::gemm_phase(lds, g, S, E); }
    PHASE_BEGIN(run);
    if (run && PM(2)) {
      for (int rep_ = 0; rep_ < DUP_P2G; ++rep_) {
      if (PM(10)) { MKB; WSL; pg8::Gemm g{b.CQ, WT(WS_WUQ), CH, 2048, 384, 384}; pg8::StaticOrder S; S.init(CH, 2048, G, bid); EpiQ E{b}; pg8::gemm_phase(lds, g, S, E); }
      if (PM(11)) { MKB; WSL; pg8::Gemm g{b.CKV, WT(WS_WUKV), CH, 2048, 256, 256}; pg8::StaticOrder S; S.init(CH, 2048, G, bid); EpiKV E{b}; pg8::gemm_phase(lds, g, S, E); }
      }
      for (int rep_ = 0; rep_ < DUP_R1; ++rep_)
      if (PM(12)) for (int it = bid; it < CH / 32; it += G) { MKB; const int h = it & 3; ret_kv_item(b, it, lg2_of(kargs()->in[4], h), lg2_of(kargs()->in[5], h), ldsg); }
    }
    PHASE_BEGIN(run);
    if (run && PM(3)) {
      if (PM(13)) { MKB; TIDS; ret_scan(b, nseq, NC, kargs()->in[4], kargs()->in[5], bid * 512 + tid, G * 512); }
      const int vb = (G % 8 == 0) ? (bid % 8) * (G / 8) + bid / 8 : bid;
      const int nqb = SL / 256, nunits = nseq * 8 * nqb;
      for (int rep_ = 0; rep_ < DUP_ATTN; ++rep_)
      if (PM(14)) for (int uidx = vb; uidx < nunits; uidx += G) { MKB; const int qb = uidx % nqb, hh = (uidx / nqb) & 7, s = uidx / (nqb * 8);
        const size_t t0 = (size_t)s * SL;
        att::attn_unit(b.Q + (t0 + (size_t)qb * 256) * 1536 + hh * 192, b.K + t0 * 1536 + hh * 192, b.V + t0 * 1024 + hh * 128, b.H1O + (t0 + (size_t)qb * 256) * 1024 + hh * 128, SL, ldsg, lds); }
    }
    PHASE_BEGIN(run);
    if (run && PM(4)) { for (int rep_ = 0; rep_ < DUP_R3; ++rep_) for (int it = bid; it < CH / 32; it += G) { MKB; const int h = it & 3; ret_out_item(b, it, lg2_of(kargs()->in[4], h), lg2_of(kargs()->in[5], h), kargs()->in[6], ldsg); } }
    PHASE_BEGIN(run);
    if (run && PM(5)) for (int rep_ = 0; rep_ < DUP_P5; ++rep_) {
      { MKB; WSL; pg8::Gemm g{b.URET, WT(WS_WRO), CH, 1024, 1024, 1024}; pg8::StaticOrder S; S.init(CH, 1024, G, bid); EpiGate<0> E{b}; pg8::gemm_phase(lds, g, S, E); }
      { MKB; WSL; pg8::Gemm g{b.H1O, WT(WS_WMO), CH, 1024, 1024, 1024}; pg8::StaticOrder S; S.init(CH, 1024, G, bid); EpiGate<1> E{b}; pg8::gemm_phase(lds, g, S, E); }
    }
    PHASE_BEGIN(run);
    if (run && PM(6)) for (int rep_ = 0; rep_ < DUP_P69; ++rep_) { MKB; WSL; pg8::Gemm g{b.RV, WT(WS_WOUT), CH, 1024, 1024, 1024}; pg8::StaticOrder S; S.init(CH, 1024, G, bid); EpiOut E{b, rep_ == 0}; pg8::gemm_phase(lds, g, S, E); }
    PHASE_BEGIN(run);
    if (run && PM(7)) for (int rep_ = 0; rep_ < DUP_P7; ++rep_) { MKB; WSL; pg8::Gemm g{b.RG, WT(WS_WUP), CH, N_UP, 1024, 1024}; pg8::StaticOrder S; S.init(CH, N_UP, G, bid); EpiUp E{b}; pg8::gemm_phase(lds, g, S, E); }
    PHASE_BEGIN(run);
    if (run && PM(8)) for (int rep_ = 0; rep_ < DUP_P8; ++rep_) { MKB; TIDS; const int vbc = (G % 8 == 0) ? (bid % 8) * (G / 8) + bid / 8 : bid;
      conv_gate(b, kargs()->in[18], kargs()->in[19], CH, vbc, G, tid); }
    PHASE_BEGIN(run);
    if (run && PM(9)) {
      for (int rep_ = 0; rep_ < DUP_P69; ++rep_) { MKB; WSL; pg8::Gemm g{b.G, WT(WS_WDN), CH, 1024, DFF, DFF}; pg8::StaticOrder S; S.init(CH, 1024, G, bid); EpiDown E{b, rep_ == 0}; pg8::gemm_phase(lds, g, S, E); }
      if (chunk + 1 < nchunk) { TIDS; const Bufs nb = make_bufs<CH>(kargs(), chunk + 1); h1_rows(nb, kargs()->in[2], CH, bid * 8 + wid, G * 8, lane); }
    }
  }
}

extern "C" void kernel_launch(void* const* d_in, const int* in_sizes, int n_in, void* d_out, int out_size,
                              void* d_ws, size_t ws_size, hipStream_t stream) {
  static int grid_blocks = 0;
  if (!grid_blocks) {
    int dev = 0, cus = 0, per_cu = 0;
    (void)hipGetDevice(&dev);
    (void)hipDeviceGetAttribute(&cus, hipDeviceAttributeMultiprocessorCount, dev);
    (void)hipFuncSetAttribute((const void*)fwd_kernel<32768>, hipFuncAttributeMaxDynamicSharedMemorySize, LDS_BYTES);
    (void)hipFuncSetAttribute((const void*)fwd_kernel<16384>, hipFuncAttributeMaxDynamicSharedMemorySize, LDS_BYTES);
    (void)hipOccupancyMaxActiveBlocksPerMultiprocessor(&per_cu, fwd_kernel<32768>, 512, LDS_BYTES);
    if (per_cu < 1) per_cu = 1;
    grid_blocks = cus * per_cu;
    if (grid_blocks > 256) grid_blocks = 256;
  }
  Args a{};
  for (int i = 0; i < 21; ++i) a.in[i] = (const float*)d_in[i];
  a.out = (float*)d_out; a.ws = (unsigned char*)d_ws;
  const bool big = WS_PERM_END + (size_t)PT_END * 32768 <= ws_size;
  a.CH = big ? 32768 : 16384; a.ph_lo = 0; a.ph_hi = 0; a.pad = 0;
  void* args[] = {&a};
  hipError_t e = hipLaunchCooperativeKernel(big ? (void*)fwd_kernel<32768> : (void*)fwd_kernel<16384>, dim3(grid_blocks), dim3(512), args, LDS_BYTES, stream);
  if (e != hipSuccess) fprintf(stderr, "cooperative launch failed: %s (grid %d)\n", hipGetErrorString(e), grid_blocks);
}
```
